# Optimizing an MI355X kernel written in HIP

```python
import jax, jax.numpy as jnp
from jax import lax
import numpy as np

D_MODEL = 1024
BATCH = 8
SEQ = 4096
DEPTH = 4

GRID_W = 64
CTX_LEN = 256
N_MIXERS = 3
Q_BLOCK = 128
ROPE_THETA = 10000.0
NORM_EPS = 1e-6
DIFF_HEADS = 8
DIFF_HEAD_DIM = 64
GQA_HEADS = 8
GQA_KV_HEADS = 2
GQA_HEAD_DIM = 128
FNET_GROUPS = 4
FNET_GROUP_DIM = D_MODEL // FNET_GROUPS
D_FF = -(-8 * D_MODEL // (3 * 256)) * 256
N_A = len(range(0, DEPTH, N_MIXERS))
N_B = len(range(1, DEPTH, N_MIXERS))
N_C = len(range(2, DEPTH, N_MIXERS))

kernel_name = "hybrid_diffattn_gqa_fnet_prefix_dit"


def rms_norm(x, g):
    xf = x.astype(jnp.float32)
    y = xf * lax.rsqrt(jnp.mean(xf * xf, axis=-1, keepdims=True) + NORM_EPS)
    return (y * g.astype(jnp.float32)).astype(x.dtype)


def modulate(h, shift, scale):
    return h * (1 + scale) + shift


def lambda_init_fn(layer_idx):
    return 0.8 - 0.6 * float(np.exp(-0.3 * layer_idx))


def axial_rope_tables(rows, cols, head_dim):
    axis_dim = head_dim // 2
    inv_freq = ROPE_THETA ** (-jnp.arange(0, axis_dim, 2, dtype=jnp.float32) / axis_dim)
    ang = jnp.concatenate([rows[:, None].astype(jnp.float32) * inv_freq,
                           cols[:, None].astype(jnp.float32) * inv_freq], axis=-1)
    return jnp.cos(ang), jnp.sin(ang)


def apply_rope(x, cos, sin):
    shape = (cos.shape[0],) + (1,) * (x.ndim - 3) + (cos.shape[-1],)
    c_, s_ = cos.reshape(shape), sin.reshape(shape)
    xf = x.astype(jnp.float32)
    x1, x2 = xf[..., 0::2], xf[..., 1::2]
    out = jnp.stack([x1 * c_ - x2 * s_, x1 * s_ + x2 * c_], axis=-1).reshape(x.shape)
    return out.astype(x.dtype)


def sweep_blocks(fn, q):
    B, S = q.shape[:2]
    nb = S // Q_BLOCK
    qb = q.reshape((B, nb, Q_BLOCK) + q.shape[2:]).swapaxes(0, 1)
    out = lax.map(fn, qb)
    return out.swapaxes(0, 1).reshape((B, S) + out.shape[3:])


def swiglu(h, w_gu, w_down):
    g, u = jnp.split(h @ w_gu, 2, axis=-1)
    return (jax.nn.silu(g) * u) @ w_down


def diff_core(q, k, v, lam):
    s = jnp.einsum('bqhmd,bkhmd->bhmqk', q, k).astype(jnp.float32) * (DIFF_HEAD_DIM ** -0.5)
    p = jax.nn.softmax(s, axis=-1)
    a = p[:, :, 0] - lam * p[:, :, 1]
    return jnp.einsum('bhqk,bkhe->bqhe', a.astype(v.dtype), v)


def diff_attention(h, hc, w_qkv, lam_vecs, subln_g, w_o, lambda_init, rope, need_ctx):
    B, L, _ = h.shape
    C = hc.shape[1]
    dq = DIFF_HEADS * 2 * DIFF_HEAD_DIM
    cos, sin = rope

    def split_q(t, n):
        return t.reshape(B, n, DIFF_HEADS, 2, DIFF_HEAD_DIM)

    q, k, v = jnp.split(h @ w_qkv, 3, axis=-1)
    q = apply_rope(split_q(q, L), cos, sin)
    k = apply_rope(split_q(k, L), cos, sin)
    v = v.reshape(B, L, DIFF_HEADS, 2 * DIFF_HEAD_DIM)
    kc, vc = jnp.split(hc @ w_qkv[:, dq:], 2, axis=-1)
    kc = split_q(kc, C)
    vc = vc.reshape(B, C, DIFF_HEADS, 2 * DIFF_HEAD_DIM)

    lv = lam_vecs.astype(jnp.float32)
    lam = jnp.exp(jnp.sum(lv[0] * lv[1])) - jnp.exp(jnp.sum(lv[2] * lv[3])) + lambda_init

    def head_out(o, n):
        o = rms_norm(o, subln_g) * (1.0 - lambda_init)
        return o.reshape(B, n, DIFF_HEADS * 2 * DIFF_HEAD_DIM) @ w_o

    k_all = jnp.concatenate([kc, k], axis=1)
    v_all = jnp.concatenate([vc, v], axis=1)
    o = sweep_blocks(lambda qb: diff_core(qb, k_all, v_all, lam), q)
    y = head_out(o, L)
    yc = None
    if need_ctx:
        qc = split_q(hc @ w_qkv[:, :dq], C)
        yc = head_out(diff_core(qc, kc, vc, lam), C)
    return y, yc


def gqa_core(q, k, v):
    s = jnp.einsum('bqhgd,bkhd->bhgqk', q, k).astype(jnp.float32) * (GQA_HEAD_DIM ** -0.5)
    p = jax.nn.softmax(s, axis=-1)
    return jnp.einsum('bhgqk,bkhd->bqhgd', p.astype(v.dtype), v)


def gqa_attention(h, hc, w_qkv, q_norm, k_norm, w_o, rope, need_ctx):
    B, L, _ = h.shape
    C = hc.shape[1]
    G = GQA_HEADS // GQA_KV_HEADS
    dq = GQA_HEADS * GQA_HEAD_DIM
    dkv = GQA_KV_HEADS * GQA_HEAD_DIM
    cos, sin = rope

    def heads(t, n):
        q = rms_norm(t[..., :dq].reshape(B, n, GQA_KV_HEADS, G, GQA_HEAD_DIM), q_norm)
        k = rms_norm(t[..., dq:dq + dkv].reshape(B, n, GQA_KV_HEADS, GQA_HEAD_DIM), k_norm)
        v = t[..., dq + dkv:].reshape(B, n, GQA_KV_HEADS, GQA_HEAD_DIM)
        return q, k, v

    q, k, v = heads(h @ w_qkv, L)
    q = apply_rope(q, cos, sin)
    k = apply_rope(k, cos, sin)
    qc, kc, vc = heads(hc @ w_qkv, C)

    k_all = jnp.concatenate([kc, k], axis=1)
    v_all = jnp.concatenate([vc, v], axis=1)
    o = sweep_blocks(lambda qb: gqa_core(qb, k_all, v_all), q)
    y = o.reshape(B, L, dq) @ w_o
    yc = gqa_core(qc, kc, vc).reshape(B, C, dq) @ w_o if need_ctx else None
    return y, yc


def fourier_mix(h, w_o, b_o):
    B, L, D = h.shape
    hf = h.astype(jnp.float32).reshape(B, L, FNET_GROUPS, FNET_GROUP_DIM)
    f = jnp.fft.fft2(hf, axes=(1, 3), norm='ortho').real.astype(h.dtype).reshape(B, L, D)
    return f @ w_o + b_o


def setup_inputs(seed: int = 0) -> dict:
    key = jax.random.key(seed)
    ks = jax.random.split(key, 24)
    f32 = jnp.float32

    def nrm(k, shape, fan_in, s=1.0):
        return jax.random.normal(k, shape, f32) * (s * fan_in ** -0.5)

    def gain(k, shape):
        return 1.0 + 0.05 * jax.random.normal(k, shape, f32)

    D = D_MODEL
    return {
        "x": jax.random.normal(ks[0], (BATCH, SEQ, D), f32),
        "c": jax.random.normal(ks[1], (BATCH, D), f32),
        "ctx": jax.random.normal(ks[2], (BATCH, CTX_LEN, D), f32),
        "c_ctx": jax.random.normal(ks[3], (D,), f32),
        "mod_w": nrm(ks[4], (DEPTH, D, 6 * D), D, 0.5),
        "mod_b": 0.01 * jax.random.normal(ks[5], (DEPTH, 6 * D), f32),
        "ln_mix": gain(ks[6], (DEPTH, D)),
        "ln_ffn": gain(ks[7], (DEPTH, D)),
        "ffn_w_gu": nrm(ks[8], (DEPTH, D, 2 * D_FF), D),
        "ffn_w_down": nrm(ks[9], (DEPTH, D_FF, D), D_FF),
        "a_w_qkv": nrm(ks[10], (N_A, D, 3 * DIFF_HEADS * 2 * DIFF_HEAD_DIM), D),
        "a_lam": 0.1 * jax.random.normal(ks[11], (N_A, 4, DIFF_HEAD_DIM), f32),
        "a_subln": gain(ks[12], (N_A, 2 * DIFF_HEAD_DIM)),
        "a_w_o": nrm(ks[13], (N_A, DIFF_HEADS * 2 * DIFF_HEAD_DIM, D), D),
        "b_w_qkv": nrm(ks[14], (N_B, D, (GQA_HEADS + 2 * GQA_KV_HEADS) * GQA_HEAD_DIM), D),
        "b_q_norm": gain(ks[15], (N_B, GQA_HEAD_DIM)),
        "b_k_norm": gain(ks[16], (N_B, GQA_HEAD_DIM)),
        "b_w_o": nrm(ks[17], (N_B, GQA_HEADS * GQA_HEAD_DIM, D), GQA_HEADS * GQA_HEAD_DIM),
        "c_w_o": nrm(ks[18], (N_C, D, D), D),
        "c_b_o": 0.01 * jax.random.normal(ks[19], (N_C, D), f32),
        "final_norm": gain(ks[20], (D,)),
    }


def reference(x, c, ctx, c_ctx, mod_w, mod_b, ln_mix, ln_ffn, ffn_w_gu, ffn_w_down,
              a_w_qkv, a_lam, a_subln, a_w_o, b_w_qkv, b_q_norm, b_k_norm, b_w_o,
              c_w_o, c_b_o, final_norm):
    B, S, D = x.shape
    ROWS = S // GRID_W
    rows = jnp.repeat(jnp.arange(ROWS, dtype=jnp.int32), GRID_W)
    cols = jnp.tile(jnp.arange(GRID_W, dtype=jnp.int32), ROWS)
    rope_a = axial_rope_tables(rows, cols, DIFF_HEAD_DIM)
    rope_b = axial_rope_tables(rows, cols, GQA_HEAD_DIM)

    xc = ctx
    for i in range(DEPTH):
        last = i == DEPTH - 1
        kind, j = i % N_MIXERS, i // N_MIXERS
        sh1, sc1, g1, sh2, sc2, g2 = [m[:, None, :] for m in
                                      jnp.split(jax.nn.silu(c) @ mod_w[i] + mod_b[i], 6, axis=-1)]
        csh1, csc1, cg1, csh2, csc2, cg2 = jnp.split(jax.nn.silu(c_ctx) @ mod_w[i] + mod_b[i], 6, axis=-1)

        h = modulate(rms_norm(x, ln_mix[i]), sh1, sc1)
        if kind == 0:
            hc = modulate(rms_norm(xc, ln_mix[i]), csh1, csc1)
            y, yc = diff_attention(h, hc, a_w_qkv[j], a_lam[j], a_subln[j], a_w_o[j],
                                   lambda_init_fn(i), rope_a, not last)
        elif kind == 1:
            hc = modulate(rms_norm(xc, ln_mix[i]), csh1, csc1)
            y, yc = gqa_attention(h, hc, b_w_qkv[j], b_q_norm[j], b_k_norm[j], b_w_o[j],
                                  rope_b, not last)
        else:
            y = fourier_mix(h, c_w_o[j], c_b_o[j])
            yc = None
            if not last:
                hc = modulate(rms_norm(xc, ln_mix[i]), csh1, csc1)
                yc = fourier_mix(hc, c_w_o[j], c_b_o[j])

        x = x + g1 * y
        x = x + g2 * swiglu(modulate(rms_norm(x, ln_ffn[i]), sh2, sc2), ffn_w_gu[i], ffn_w_down[i])
        if not last:
            xc = xc + cg1 * yc
            xc = xc + cg2 * swiglu(modulate(rms_norm(xc, ln_ffn[i]), csh2, csc2),
                                   ffn_w_gu[i], ffn_w_down[i])

    return rms_norm(x, final_norm)
```

```cpp
#include <hip/hip_runtime.h>
#include <hip/hip_bf16.h>
#include <hip/hip_cooperative_groups.h>
#include <cstdio>
#include <cstdint>
namespace cg = cooperative_groups;

#ifndef MK_PER_PHASE
#define MK_PER_PHASE 0
#endif

constexpr int NB = 8, SEQ = 4096, DM = 1024, CTXL = 256, RPB = SEQ + CTXL  , MROWS = NB * RPB  ;
constexpr int DFF = 2816, NTILE_B = RPB / 256  ;
constexpr float EPS = 1e-6f;
constexpr float LAMINIT0 = 0.2f, LAMINIT3 = 0.55605820415564054f;

constexpr size_t MiB = 1u << 20;
constexpr size_t WS_MODV = 0;
constexpr size_t WS_ROPEA = 1 * MiB;
constexpr size_t WS_ROPEB = 1 * MiB + 65536;
constexpr size_t WS_CSCTX = 2 * MiB;
constexpr size_t WS_DC = 2 * MiB + 512 * 1024;
constexpr size_t WS_BAR = 3 * MiB;
constexpr size_t WS_CNT = 3 * MiB + 65536;
constexpr size_t WS_XBUF = 3 * MiB + 524288;
constexpr size_t WS_XC = 4 * MiB;
constexpr size_t WS_WQKVA = 12 * MiB;
constexpr size_t WS_WOA = 24 * MiB;
constexpr size_t WS_WQKVB = 28 * MiB;
constexpr size_t WS_WOB = 31 * MiB;
constexpr size_t WS_WOC = 33 * MiB;
constexpr size_t WS_WGU = 35 * MiB;
constexpr size_t WS_WDN = 79 * MiB;
constexpr size_t WS_R3 = 101 * MiB;
constexpr size_t WS_R2 = 169 * MiB;
constexpr size_t WS_R1 = 305 * MiB;
constexpr size_t WS_END = 509 * MiB;
constexpr size_t R2_CS_OFF = 68 * MiB;
constexpr size_t R3_HTC_OFF = 64 * MiB;

constexpr int LDS_BYTES = 147456;

typedef unsigned short bf16_t;
typedef short bf16x8 __attribute__((ext_vector_type(8)));
typedef short s16x4 __attribute__((ext_vector_type(4)));
typedef float f32x4 __attribute__((ext_vector_type(4)));
typedef float f32x2 __attribute__((ext_vector_type(2)));
typedef float f32x16 __attribute__((ext_vector_type(16)));
typedef unsigned u32x4 __attribute__((ext_vector_type(4)));
typedef unsigned u32x2 __attribute__((ext_vector_type(2)));
#define LAS __attribute__((address_space(3)))

__device__ __forceinline__ unsigned cvt_pk_bf16(float lo, float hi) { unsigned r; asm volatile("v_cvt_pk_bf16_f32 %0, %1, %2" : "=v"(r) : "v"(lo), "v"(hi)); return r; }
__device__ __forceinline__ unsigned f2bf(float f) { unsigned u = __builtin_bit_cast(unsigned, f); return (u + 0x7fffu + ((u >> 16) & 1u)) >> 16; }
__device__ __forceinline__ float bflo(unsigned u) { return __builtin_bit_cast(float, u << 16); }
__device__ __forceinline__ float bfhi(unsigned u) { return __builtin_bit_cast(float, u & 0xffff0000u); }
__device__ __forceinline__ int tid_l() { int t = threadIdx.x; asm volatile("" : "+v"(t)); return t; }
__device__ __forceinline__ float wave_sum(float v) {
#pragma unroll
    for (int o = 1; o < 64; o <<= 1) v += __shfl_xor(v, o);
    return v;
}
__device__ __forceinline__ float sum16(float v) { v += __shfl_xor(v, 1); v += __shfl_xor(v, 2); v += __shfl_xor(v, 4); v += __shfl_xor(v, 8); return v; }
__device__ __forceinline__ float silu_f(float g) { return g * __builtin_amdgcn_rcpf(1.0f + __builtin_amdgcn_exp2f(-1.4426950408889634f * g)); }

#ifndef SPLITK_CTX
#define SPLITK_CTX 1
#endif
namespace pg8 {
constexpr int BM = 256, BK = 64, HALF = 128, HTB = HALF * BK * 2, STAGE_BYTES = 8 * HTB, NXCD = 8, WGM = 4;
__device__ __forceinline__ int lds_byte(int r, int c) { const int st = (r >> 4) * 2 + (c >> 5), rr = r & 15, cc = c & 31, ob = rr * 64 + cc * 2; return st * 1024 + (ob ^ (((ob >> 9) & 1) << 5)); }
__device__ __forceinline__ void stage_rc(int b, int& R, int& C) { const int st = b / 1024, sb = b % 1024, swz = sb ^ (((sb >> 9) & 1) << 5); R = (st >> 1) * 16 + swz / 64; C = (st & 1) * 32 + (swz % 64) / 2; }
__device__ __forceinline__ int perm32(int rho) { const int n = rho >> 4, i = rho & 15; return 8 * (i >> 2) + 4 * n + (i & 3); }

struct Unit { int pm, pn, z; };
struct Gemm { const bf16_t* A; const bf16_t* Bt; int lda, ldb, K; size_t aZ, bZ; };

struct Order {
    int nM, nN, nZ, nwg, G, c, mode;
    __device__ void init(int nM_, int nN_, int nZ_, int G_, int c_, int mode_ = 0) { nM = nM_; nN = nN_; nZ = nZ_; nwg = nM * nN * nZ; G = G_; c = c_; mode = mode_; }
    __device__ bool next(int i, Unit& u) const {
        const long L = (long)i * G + c; if (L >= nwg) return false;
        int wgid = (int)L; { const int q = nwg / NXCD, r = nwg % NXCD, xcd = wgid % NXCD, off = wgid / NXCD; wgid = (xcd < r ? xcd * (q + 1) : r * (q + 1) + (xcd - r) * q) + off; }
        const int per = nM * nN; u.z = wgid / per; wgid -= u.z * per;
        const int nig = WGM * nN, gid = wgid / nig, fm = gid * WGM, gsz = (nM - fm) < WGM ? (nM - fm) : WGM;
        const int pm = fm + ((wgid % nig) % gsz); u.pn = (wgid % nig) / gsz;
        u.pm = (mode == 1) ? pm * NTILE_B : (mode == 2) ? pm + (pm >> 4) + 1 : pm; return true;
    }
};

struct EpiStore {
    bf16_t* O; int ldc; size_t oZ; const float* rope; int rope_tiles;
    __device__ __forceinline__ void operator()(f32x4 (&acc)[2][2][4][2], const Unit& u, int wr, int wc, int fr, int fq) const {
        bf16_t* base = O + (size_t)u.z * oZ + (size_t)(u.pm * BM + wr * 64 + fr) * ldc + u.pn * BM + wc * 32 + 8 * fq;
        const int tt = u.pm % NTILE_B; const bool do_rope = rope && u.pn < rope_tiles && tt != 0;
        const float qs = (rope && u.pn < 4) ? 0.125f * 1.4426950408889634f : 1.0f;
#pragma unroll
        for (int ai = 0; ai < 2; ++ai)
#pragma unroll
            for (int m = 0; m < 4; ++m) { bf16_t* rowp = base + (size_t)(ai * HALF + m * 16) * ldc;
                f32x4 cs0 = (f32x4){1.f, 0.f, 1.f, 0.f}, cs1 = cs0;
                if (do_rope) { const int tl = (tt - 1) * 256 + ai * HALF + wr * 64 + m * 16 + fr, pos = (wc & 1) ? (tl & 63) : (tl >> 6);
                    const float* tp = rope + (pos * 16 + 4 * fq) * 2; cs0 = *(const f32x4*)tp; cs1 = *(const f32x4*)(tp + 4); }
#pragma unroll
                for (int bj = 0; bj < 2; ++bj) { const f32x4 v0 = acc[ai][bj][m][0] * qs, v1 = acc[ai][bj][m][1] * qs;
                    u32x4 w; w.x = cvt_pk_bf16(v0[0] * cs0.x - v0[1] * cs0.y, v0[0] * cs0.y + v0[1] * cs0.x); w.y = cvt_pk_bf16(v0[2] * cs0.z - v0[3] * cs0.w, v0[2] * cs0.w + v0[3] * cs0.z);
                    w.z = cvt_pk_bf16(v1[0] * cs1.x - v1[1] * cs1.y, v1[0] * cs1.y + v1[1] * cs1.x); w.w = cvt_pk_bf16(v1[2] * cs1.z - v1[3] * cs1.w, v1[2] * cs1.w + v1[3] * cs1.z);
                    *(u32x4*)(rowp + bj * HALF) = w; } }
    }
};
struct EpiPosDft {
    static constexpr bool PREFETCH = false;
    bf16_t* T; int row_off; int N;
    __device__ __forceinline__ void operator()(f32x4 (&acc)[2][2][4][2], const Unit& u, int wr, int wc, int fr, int fq) const {
        const size_t rowb = (size_t)u.z * RPB + row_off; const int colb = u.pn * 512 + wc * 32 + 8 * fq;
#pragma unroll
        for (int ai = 0; ai < 2; ++ai)
#pragma unroll
            for (int m = 0; m < 4; ++m) { const int k = u.pm * HALF + wr * 64 + m * 16 + fr;
#pragma unroll
                for (int bj = 0; bj < 2; ++bj) { const f32x4 v0 = acc[ai][bj][m][0], v1 = acc[ai][bj][m][1];
                    u32x4 w; w.x = cvt_pk_bf16(v0[0], v0[1]); w.y = cvt_pk_bf16(v0[2], v0[3]); w.z = cvt_pk_bf16(v1[0], v1[1]); w.w = cvt_pk_bf16(v1[2], v1[3]);
                    const int col = colb + bj * HALF;
                    if (ai == 1 && k == 0) { const u32x4 zz = {0u, 0u, 0u, 0u};
                        *(u32x4*)(T + (rowb + N / 2) * 2048 + col) = w; *(u32x4*)(T + (rowb + N / 2) * 2048 + col + 256) = zz; *(u32x4*)(T + rowb * 2048 + col + 256) = zz; }
                    else { *(u32x4*)(T + (rowb + k) * 2048 + col + ai * 256) = w;
                        if (k != 0) { u32x4 wm = w; if (ai) { wm.x ^= 0x80008000u; wm.y ^= 0x80008000u; wm.z ^= 0x80008000u; wm.w ^= 0x80008000u; }
                            *(u32x4*)(T + (rowb + N - k) * 2048 + col + ai * 256) = wm; } } } }
    }
};
struct EpiSwiGLU {
    bf16_t* O;
    __device__ __forceinline__ void operator()(f32x4 (&acc)[2][2][4][2], const Unit& u, int wr, int wc, int fr, int fq) const {
        bf16_t* base = O + (size_t)(u.pm * BM + wr * 64 + fr) * DFF + u.pn * HALF + wc * 32 + 8 * fq;
#pragma unroll
        for (int ai = 0; ai < 2; ++ai)
#pragma unroll
            for (int m = 0; m < 4; ++m) { bf16_t* rowp = base + (size_t)(ai * HALF + m * 16) * DFF;
                const f32x4 g0 = acc[ai][0][m][0], g1 = acc[ai][0][m][1], u0 = acc[ai][1][m][0], u1 = acc[ai][1][m][1];
                u32x4 w; w.x = cvt_pk_bf16(silu_f(g0[0]) * u0[0], silu_f(g0[1]) * u0[1]); w.y = cvt_pk_bf16(silu_f(g0[2]) * u0[2], silu_f(g0[3]) * u0[3]);
                w.z = cvt_pk_bf16(silu_f(g1[0]) * u1[0], silu_f(g1[1]) * u1[1]); w.w = cvt_pk_bf16(silu_f(g1[2]) * u1[2], silu_f(g1[3]) * u1[3]);
                *(u32x4*)rowp = w; }
    }
};
struct EpiResid {
    const float* xin_l; const float* xin_c; float* xout_l; float* xout_c; const float* gate; const float* bias; float* part;
    int hmode; bf16_t* H; const float* nln; const float* nmod; float* xbuf; unsigned* cnt; LAS unsigned char* xl;
    __device__ __forceinline__ void operator()(f32x4 (&acc)[2][2][4][2], const Unit& u, int wr, int wc, int fr, int fq) const {
        const int b = u.pm / NTILE_B, tt = u.pm - b * NTILE_B; const bool isc = (tt == 0);
        const int col0 = u.pn * BM + wc * 32 + 8 * fq;
        if (part) {
            float* P = part + ((size_t)u.z * (NB * CTXL) + (size_t)b * CTXL + wr * 64 + fr) * DM + col0;
#pragma unroll
            for (int ai = 0; ai < 2; ++ai)
#pragma unroll
                for (int m = 0; m < 4; ++m) { const size_t ro = (size_t)(ai * HALF + m * 16) * DM;
#pragma unroll
                    for (int bj = 0; bj < 2; ++bj)
#pragma unroll
                        for (int n = 0; n < 2; ++n) *(f32x4*)(P + ro + bj * HALF + 4 * n) = acc[ai][bj][m][n]; }
            return;
        }
        const size_t rowbase = isc ? (size_t)b * CTXL : (size_t)b * SEQ + (size_t)(tt - 1) * 256;
        const float* xin = (isc ? xin_c : xin_l) + (rowbase + wr * 64 + fr) * DM; float* xout = (isc ? xout_c : xout_l) + (rowbase + wr * 64 + fr) * DM;
        const float* g = gate + (isc ? 8 : b) * 6144 + col0;
        if (bias) {
#pragma unroll
            for (int bj = 0; bj < 2; ++bj)
#pragma unroll
                for (int n = 0; n < 2; ++n) { const f32x4 bv = *(const f32x4*)(bias + col0 + bj * HALF + 4 * n);
#pragma unroll
                    for (int ai = 0; ai < 2; ++ai)
#pragma unroll
                        for (int m = 0; m < 4; ++m) acc[ai][bj][m][n] += bv; }
        }
        f32x4 gv[2][2];
#pragma unroll
        for (int bj = 0; bj < 2; ++bj)
#pragma unroll
            for (int n = 0; n < 2; ++n) gv[bj][n] = *(const f32x4*)(g + bj * HALF + 4 * n);
#pragma unroll
        for (int ai = 0; ai < 2; ++ai) {
            f32x4 xi[4][2][2];
#pragma unroll
            for (int m = 0; m < 4; ++m)
#pragma unroll
                for (int bj = 0; bj < 2; ++bj)
#pragma unroll
                    for (int n = 0; n < 2; ++n) xi[m][bj][n] = *(const f32x4*)(xin + (size_t)(ai * HALF + m * 16) * DM + col0 + bj * HALF + 4 * n);
            asm volatile("s_waitcnt vmcnt(0)" ::: "memory");
#pragma unroll
            for (int m = 0; m < 4; ++m)
#pragma unroll
                for (int bj = 0; bj < 2; ++bj)
#pragma unroll
                    for (int n = 0; n < 2; ++n) { acc[ai][bj][m][n] = xi[m][bj][n] + gv[bj][n] * acc[ai][bj][m][n];
                        if (hmode != 2) *(f32x4*)(xout + (size_t)(ai * HALF + m * 16) * DM + col0 + bj * HALF + 4 * n) = acc[ai][bj][m][n]; }
            asm volatile("" ::: "memory");
        }
        if (hmode == 0) return;
        LAS float* P = (LAS float*)xl; LAS float* S = (LAS float*)(xl + 4096);
        const int tid = tid_l(), lane = tid & 63, wid = tid >> 6, pmi = b * 16 + (tt - 1);
#pragma unroll
        for (int ai = 0; ai < 2; ++ai)
#pragma unroll
            for (int m = 0; m < 4; ++m) { float s = 0.f;
#pragma unroll
                for (int bj = 0; bj < 2; ++bj)
#pragma unroll
                    for (int n = 0; n < 2; ++n) { const f32x4 a = acc[ai][bj][m][n]; s += (a[0] * a[0] + a[1] * a[1]) + (a[2] * a[2] + a[3] * a[3]); }
                s += __shfl_xor(s, 16); s += __shfl_xor(s, 32);
                if (fq == 0) P[(ai * HALF + wr * 64 + m * 16 + fr) * 4 + wc] = s; }
        asm volatile("s_waitcnt lgkmcnt(0)" ::: "memory"); __builtin_amdgcn_s_barrier(); asm volatile("" ::: "memory");
        const int prow = wid * 32 + (lane & 31);
        if (lane < 32) { const f32x4 q4 = *(const LAS f32x4*)(P + prow * 4);
            __hip_atomic_store(xbuf + ((size_t)pmi * 256 + prow) * 4 + u.pn, (q4[0] + q4[1]) + (q4[2] + q4[3]), __ATOMIC_RELAXED, __HIP_MEMORY_SCOPE_AGENT); }
        asm volatile("s_waitcnt vmcnt(0)" ::: "memory");
        if (lane == 0) __hip_atomic_fetch_add(cnt + 64 * pmi, 1u, __ATOMIC_RELAXED, __HIP_MEMORY_SCOPE_AGENT);
        if (wid == 0) { unsigned sp = 0;
            while ((unsigned)__builtin_amdgcn_readfirstlane(__hip_atomic_load(cnt + 64 * pmi, __ATOMIC_RELAXED, __HIP_MEMORY_SCOPE_AGENT)) < 32u) { __builtin_amdgcn_s_sleep(1); if (++sp > (1u << 22)) break; }
            }
        asm volatile("s_waitcnt vmcnt(0) lgkmcnt(0)" ::: "memory"); __builtin_amdgcn_s_barrier(); asm volatile("" ::: "memory");
        if (lane < 32) { const float* sl4 = xbuf + ((size_t)pmi * 256 + prow) * 4; float tsum = 0.f;
#pragma unroll
            for (int t = 0; t < 4; ++t) tsum += __hip_atomic_load(sl4 + t, __ATOMIC_RELAXED, __HIP_MEMORY_SCOPE_AGENT);
            S[prow] = __builtin_amdgcn_rsqf(tsum * (1.0f / DM) + EPS); }
        asm volatile("s_waitcnt vmcnt(0) lgkmcnt(0)" ::: "memory"); __builtin_amdgcn_s_barrier(); asm volatile("" ::: "memory");
        int c0 = col0, rl = wr * 64 + fr; asm volatile("" : "+v"(c0), "+v"(rl));
        f32x4 Am[2][2], Bm[2][2];
#pragma unroll
        for (int bj = 0; bj < 2; ++bj)
#pragma unroll
            for (int n = 0; n < 2; ++n) { const int c = c0 + bj * HALF + 4 * n; const f32x4 l4 = *(const f32x4*)(nln + c);
                if (hmode == 1) { Am[bj][n] = l4 * (*(const f32x4*)(nmod + b * 6144 + 1024 + c) + 1.0f); Bm[bj][n] = *(const f32x4*)(nmod + b * 6144 + c); }
                else { Am[bj][n] = l4; Bm[bj][n] = (f32x4){0.f, 0.f, 0.f, 0.f}; } }
        bf16_t* hbase = H + ((size_t)u.pm * BM + rl) * DM + c0; float* obase = (isc ? xout_c : xout_l) + (rowbase + rl) * DM + c0;
#pragma unroll
        for (int ai = 0; ai < 2; ++ai)
#pragma unroll
            for (int m = 0; m < 4; ++m) { const int r = ai * HALF + m * 16; const float rs = S[r + rl];
                if (hmode == 1) {
#pragma unroll
                    for (int bj = 0; bj < 2; ++bj) { const f32x4 y0 = acc[ai][bj][m][0] * rs * Am[bj][0] + Bm[bj][0], y1 = acc[ai][bj][m][1] * rs * Am[bj][1] + Bm[bj][1];
                        u32x4 w; w.x = cvt_pk_bf16(y0[0], y0[1]); w.y = cvt_pk_bf16(y0[2], y0[3]); w.z = cvt_pk_bf16(y1[0], y1[1]); w.w = cvt_pk_bf16(y1[2], y1[3]);
                        *(u32x4*)(hbase + (size_t)r * DM + bj * HALF) = w; } }
                else {
#pragma unroll
                    for (int bj = 0; bj < 2; ++bj)
#pragma unroll
                        for (int n = 0; n < 2; ++n) *(f32x4*)(obase + (size_t)r * DM + bj * HALF + 4 * n) = acc[ai][bj][m][n] * rs * Am[bj][n]; } }
    }
};

template <class Epi>
__device__ __forceinline__ void gemm_phase(LAS unsigned char* lds, const Gemm g, const Order& S, const Epi& E) {
    const int tid = tid_l(), wid = __builtin_amdgcn_readfirstlane(tid >> 6), lane = tid & 63, wr = wid >> 2, wc = wid & 3, fr = lane & 15, fq = lane >> 4;
    const int K = g.K, nt = K / BK;
    unsigned voffA[2], voffB[2];
#pragma unroll
    for (int i = 0; i < 2; ++i) { int R, C; stage_rc(tid * 16 + i * 8192, R, C); const int Rb = (R & ~31) + perm32(R & 31);
        voffA[i] = (unsigned)(R * g.lda + C) * 2u; voffB[i] = (unsigned)(Rb * g.ldb + C) * 2u; }
    const size_t kstep = (size_t)(BK * 2);
    const size_t hsA = (size_t)HALF * g.lda * 2, hsB = (size_t)HALF * g.ldb * 2;
    const size_t tsA = 2 * hsA, tsB = 2 * hsB;
    const unsigned ldsw = (unsigned)wid * 1024u;
    const int aoff = lds_byte(wr * 64 + fr, fq * 8), boff = lds_byte(wc * 32 + fr, fq * 8);
#define PG8_SA(b, h) (((b) * 2 + (h)) * HTB)
#define PG8_SB(b, h) ((4 + (b) * 2 + (h)) * HTB)
#define PG8_STAGE(bufoff, gbase, voff) do { _Pragma("unroll") for (int _i = 0; _i < 2; ++_i) \
        __builtin_amdgcn_global_load_lds((const unsigned*)((const char*)(gbase) + (voff)[_i]), (LAS unsigned*)(lds + (bufoff) + ldsw + _i * 8192), 16, 0, 0); } while (0)
#define PG8_LDA(dst, b, h) do { _Pragma("unroll") for (int m = 0; m < 4; ++m) _Pragma("unroll") for (int k = 0; k < 2; ++k) dst[m][k] = *(const LAS bf16x8*)(lds + PG8_SA(b, h) + aoff + m * 2048 + k * 1024); } while (0)
#define PG8_LDB(dst, b, h) do { _Pragma("unroll") for (int n = 0; n < 2; ++n) _Pragma("unroll") for (int k = 0; k < 2; ++k) dst[n][k] = *(const LAS bf16x8*)(lds + PG8_SB(b, h) + boff + n * 2048 + k * 1024); } while (0)
#define PG8_MMA(ai, bj, At, Bt) do { __builtin_amdgcn_s_setprio(1); _Pragma("unroll") for (int m = 0; m < 4; ++m) _Pragma("unroll") for (int n = 0; n < 2; ++n) _Pragma("unroll") for (int k = 0; k < 2; ++k) \
        acc[ai][bj][m][n] = __builtin_amdgcn_mfma_f32_16x16x32_bf16(Bt[n][k], At[m][k], acc[ai][bj][m][n], 0, 0, 0); __builtin_amdgcn_s_setprio(0); } while (0)
#define PG8_WAIT_V(n) asm volatile("s_waitcnt vmcnt(" #n ")" ::: "memory")
#define PG8_WAIT_L(n) asm volatile("s_waitcnt lgkmcnt(" #n ")" ::: "memory")
#define PG8_BAR __builtin_amdgcn_s_barrier()
#define PG8_SCHED __builtin_amdgcn_sched_barrier(0)
    Unit cur, nxt; int ui = 0;
    if (!S.next(0, cur)) return;
    f32x4 acc[2][2][4][2];
#pragma unroll
    for (int a = 0; a < 2; ++a)
#pragma unroll
        for (int b = 0; b < 2; ++b)
#pragma unroll
            for (int m = 0; m < 4; ++m)
#pragma unroll
                for (int n = 0; n < 2; ++n) acc[a][b][m][n] = (f32x4){0.f, 0.f, 0.f, 0.f};
    bf16x8 At[4][2], B0[2][2], B1[2][2];
    const char* cA = (const char*)g.A + (size_t)cur.z * g.aZ + (size_t)cur.pm * tsA; const char* cB = (const char*)g.Bt + (size_t)cur.z * g.bZ + (size_t)cur.pn * tsB;
    PG8_STAGE(PG8_SB(0, 0), cB, voffB); PG8_STAGE(PG8_SB(0, 1), cB + hsB, voffB); PG8_STAGE(PG8_SA(0, 0), cA, voffA); PG8_STAGE(PG8_SA(0, 1), cA + hsA, voffA);
    if (wr == 1) PG8_BAR;
    PG8_WAIT_V(2); PG8_BAR;
    PG8_STAGE(PG8_SB(1, 0), cB + kstep, voffB); PG8_STAGE(PG8_SA(1, 0), cA + kstep, voffA); PG8_STAGE(PG8_SB(1, 1), cB + hsB + kstep, voffB);
    PG8_WAIT_V(6); PG8_BAR;
    for (;;) {
        const bool has_next = S.next(ui + 1, nxt);
        const char* nA = has_next ? (const char*)g.A + (size_t)nxt.z * g.aZ + (size_t)nxt.pm * tsA : cA; const char* nB = has_next ? (const char*)g.Bt + (size_t)nxt.z * g.bZ + (size_t)nxt.pn * tsB : cB;
        for (int t = 0; t < nt; t += 2) {
            const bool last = (t == nt - 2);
            const char* a1 = cA + (size_t)(t + 1) * kstep;
            const char* a2 = last ? nA : cA + (size_t)(t + 2) * kstep; const char* b2 = last ? nB : cB + (size_t)(t + 2) * kstep;
            const char* a3 = a2 + kstep; const char* b3 = b2 + kstep;
            PG8_LDB(B0, 0, 0); PG8_LDB(B1, 0, 1); PG8_SCHED; PG8_LDA(At, 0, 0); PG8_STAGE(PG8_SA(1, 1), a1 + hsA, voffA);
            PG8_WAIT_V(8); PG8_WAIT_L(0); PG8_BAR; PG8_MMA(0, 0, At, B0); PG8_MMA(0, 1, At, B1); PG8_BAR; PG8_SCHED;
            PG8_LDA(At, 0, 1); PG8_STAGE(PG8_SB(0, 0), b2, voffB); PG8_STAGE(PG8_SB(0, 1), b2 + hsB, voffB); PG8_STAGE(PG8_SA(0, 0), a2, voffA);
            PG8_WAIT_V(8); PG8_WAIT_L(0); PG8_BAR; PG8_MMA(1, 0, At, B0); PG8_MMA(1, 1, At, B1); PG8_BAR; PG8_SCHED;
            PG8_LDB(B0, 1, 0); PG8_LDB(B1, 1, 1); PG8_SCHED; PG8_LDA(At, 1, 0); PG8_STAGE(PG8_SA(0, 1), a2 + hsA, voffA);
            PG8_WAIT_V(8); PG8_WAIT_L(0); PG8_BAR; PG8_MMA(0, 0, At, B0); PG8_MMA(0, 1, At, B1); PG8_BAR; PG8_SCHED;
            PG8_LDA(At, 1, 1); PG8_STAGE(PG8_SB(1, 0), b3, voffB); PG8_STAGE(PG8_SB(1, 1), b3 + hsB, voffB); PG8_STAGE(PG8_SA(1, 0), a3, voffA);
            PG8_WAIT_V(8); PG8_WAIT_L(0); PG8_BAR; PG8_MMA(1, 0, At, B0); PG8_MMA(1, 1, At, B1); PG8_BAR; PG8_SCHED;
        }
        if (wr == 0) PG8_BAR;
        E(acc, cur, wr, wc, fr, fq);
        if (!has_next) break;
#pragma unroll
        for (int a = 0; a < 2; ++a)
#pragma unroll
            for (int b = 0; b < 2; ++b)
#pragma unroll
                for (int m = 0; m < 4; ++m)
#pragma unroll
                    for (int n = 0; n < 2; ++n) acc[a][b][m][n] = (f32x4){0.f, 0.f, 0.f, 0.f};
        cur = nxt; cA = nA; cB = nB; ++ui;
        if (wr == 1) PG8_BAR;
    }
    PG8_WAIT_V(0);
    PG8_BAR;
#undef PG8_SA
#undef PG8_SB
#undef PG8_STAGE
#undef PG8_LDA
#undef PG8_LDB
#undef PG8_MMA
#undef PG8_WAIT_V
#undef PG8_WAIT_L
#undef PG8_BAR
#undef PG8_SCHED
}
}

namespace att {
constexpr int NW = 8, QBLK = 32, KVBLK = 64;
constexpr size_t SHM_V = KVBLK * 128 * 2, SHM_K = KVBLK * 128 * 2, SHM_ATTN = 2 * SHM_V + 2 * SHM_K + NW * 64 * 4;
#define KSWZ(row, colB) ((row) * 256 + ((colB) ^ (((row) & 7) << 4)))
#define SBAR() __builtin_amdgcn_sched_barrier(0)
__device__ __forceinline__ int crow(int r, int hi) { return (r & 3) + 8 * (r >> 2) + 4 * hi; }
__device__ __forceinline__ unsigned cvtpk(float lo, float hi) { unsigned r; asm volatile("v_cvt_pk_bf16_f32 %0, %1, %2" : "=v"(r) : "v"(lo), "v"(hi)); return r; }

__device__ __forceinline__ void partialSM(f32x16& p0, f32x16& p1, float& m_reg, float& mn, float& alpha, const float C, const float thr_raw) {
  float pmax = p0[0];
#pragma unroll
  for (int r = 1; r < 16; ++r) pmax = fmaxf(pmax, p0[r]);
#pragma unroll
  for (int r = 0; r < 16; ++r) pmax = fmaxf(pmax, p1[r]);
  { auto rr = __builtin_amdgcn_permlane32_swap(__float_as_uint(pmax), __float_as_uint(pmax), false, false);
    pmax = fmaxf(__uint_as_float(rr[0]), __uint_as_float(rr[1])); }
  if (__builtin_expect(__all(pmax - m_reg <= thr_raw), 1)) { mn = m_reg; alpha = 1.f; }
  else { mn = fmaxf(m_reg, pmax); alpha = __builtin_amdgcn_exp2f((m_reg - mn) * C); m_reg = mn; }
  float mnC = -mn * C;
#pragma unroll
  for (int r = 0; r < 16; ++r) p0[r] = fmaf(p0[r], C, mnC);
#pragma unroll
  for (int r = 0; r < 16; ++r) p1[r] = fmaf(p1[r], C, mnC);
#pragma unroll
  for (int r = 0; r < 16; ++r) p0[r] = __builtin_amdgcn_exp2f(p0[r]);
}
__device__ __forceinline__ void partialSM_pre(f32x16& p0, f32x16& p1, float& m_ref, float& alpha, const float thr2) {
  if (__builtin_expect(__any(m_ref != 0.f), 0)) {
#pragma unroll
    for (int r = 0; r < 16; ++r) { p0[r] -= m_ref; p1[r] -= m_ref; } }
  float pmax = p0[0];
#pragma unroll
  for (int r = 1; r < 16; ++r) pmax = fmaxf(pmax, p0[r]);
#pragma unroll
  for (int r = 0; r < 16; ++r) pmax = fmaxf(pmax, p1[r]);
  { auto rr = __builtin_amdgcn_permlane32_swap(__float_as_uint(pmax), __float_as_uint(pmax), false, false);
    pmax = fmaxf(__uint_as_float(rr[0]), __uint_as_float(rr[1])); }
  if (__builtin_expect(__all(pmax <= thr2), 1)) { alpha = 1.f; }
  else { const float dl = fmaxf(pmax, 0.f); m_ref += dl; alpha = __builtin_amdgcn_exp2f(-dl);
#pragma unroll
    for (int r = 0; r < 16; ++r) { p0[r] -= dl; p1[r] -= dl; } }
#pragma unroll
  for (int r = 0; r < 16; ++r) p0[r] = __builtin_amdgcn_exp2f(p0[r]);
}
__device__ __forceinline__ void finishSM(f32x16& p0, f32x16& p1, float alpha, float& l_reg, bf16x8& pa0, bf16x8& pa1, bf16x8& pa2, bf16x8& pa3) {
#pragma unroll
  for (int r = 0; r < 16; ++r) p1[r] = __builtin_amdgcn_exp2f(p1[r]);
  float ps = 0;
#pragma unroll
  for (int r = 0; r < 16; ++r) ps += p0[r];
#pragma unroll
  for (int r = 0; r < 16; ++r) ps += p1[r];
  { auto rr = __builtin_amdgcn_permlane32_swap(__float_as_uint(ps), __float_as_uint(ps), false, false);
    ps = __uint_as_float(rr[0]) + __uint_as_float(rr[1]); }
  l_reg = l_reg * alpha + ps;
#define PK4(P, BASE, OUT) do { unsigned a0 = cvtpk(P[BASE + 0], P[BASE + 1]), a1 = cvtpk(P[BASE + 2], P[BASE + 3]);   \
    unsigned b0 = cvtpk(P[BASE + 4], P[BASE + 5]), b1 = cvtpk(P[BASE + 6], P[BASE + 7]);                              \
    auto r0 = __builtin_amdgcn_permlane32_swap(a0, b0, false, false); auto r1 = __builtin_amdgcn_permlane32_swap(a1, b1, false, false); \
    u32x4 w = {r0[0], r1[0], r0[1], r1[1]}; OUT = *reinterpret_cast<bf16x8*>(&w); } while (0)
  PK4(p0, 0, pa0); PK4(p0, 8, pa1); PK4(p1, 0, pa2); PK4(p1, 8, pa3);
#undef PK4
}
template <int ND0>
__device__ __forceinline__ void qkt(f32x16& p0, f32x16& p1, const char* Ks, const bf16x8* qr, int r32, int hi) {
  p0 = f32x16{}; p1 = f32x16{};
#pragma unroll
  for (int d0 = 0; d0 < ND0; ++d0) { int cb = (d0 * 16 + hi * 8) * 2;
    bf16x8 b0 = *reinterpret_cast<const bf16x8*>(Ks + KSWZ(r32, cb));
    bf16x8 b1 = *reinterpret_cast<const bf16x8*>(Ks + KSWZ(32 + r32, cb));
    p0 = __builtin_amdgcn_mfma_f32_32x32x16_bf16(b0, qr[d0], p0, 0, 0, 0);
    p1 = __builtin_amdgcn_mfma_f32_32x32x16_bf16(b1, qr[d0], p1, 0, 0, 0); }
}
__device__ __forceinline__ int v_st(int k, int c) { const int kk = (k & ~0xC) | ((k & 4) << 1) | ((k & 8) >> 1); return ((kk >> 3) * 4 + (c >> 5)) * 512 + ((kk & 7) * 32 + (c & 31)) * 2; }
__device__ __forceinline__ int v_rd_base(int lane) { return ((lane & 3) << 3) | (((lane >> 2) & 3) << 6) | (((lane >> 4) & 1) << 5) | (((lane >> 5) & 1) << 8); }
constexpr int v_rd_off(int d0, int ks, int half) { return d0 * 512 + ks * 4096 + half * 2048; }
template <int OFF> __device__ __forceinline__ s16x4 tr_read(int vb) {
  s16x4 r; asm volatile("ds_read_b64_tr_b16 %0, %1 offset:%2" : "=&v"(r) : "v"(vb), "i"(OFF) : "memory"); return r;
}
template <int D0> __device__ __forceinline__ void pv_one(f32x16& od, int vb, bf16x8 pa0, bf16x8 pa1, bf16x8 pa2, bf16x8 pa3) {
  const s16x4 l0 = tr_read<v_rd_off(D0, 0, 0)>(vb), h0 = tr_read<v_rd_off(D0, 0, 1)>(vb), l1 = tr_read<v_rd_off(D0, 1, 0)>(vb), h1 = tr_read<v_rd_off(D0, 1, 1)>(vb);
  const s16x4 l2 = tr_read<v_rd_off(D0, 2, 0)>(vb), h2 = tr_read<v_rd_off(D0, 2, 1)>(vb), l3 = tr_read<v_rd_off(D0, 3, 0)>(vb), h3 = tr_read<v_rd_off(D0, 3, 1)>(vb);
  asm volatile("s_waitcnt lgkmcnt(0)" ::: "memory"); SBAR();
#define PK(L, H) (bf16x8){L[0], L[1], L[2], L[3], H[0], H[1], H[2], H[3]}
  od = __builtin_amdgcn_mfma_f32_32x32x16_bf16(pa0, PK(l0, h0), od, 0, 0, 0);
  od = __builtin_amdgcn_mfma_f32_32x32x16_bf16(pa1, PK(l1, h1), od, 0, 0, 0);
  od = __builtin_amdgcn_mfma_f32_32x32x16_bf16(pa2, PK(l2, h2), od, 0, 0, 0);
  od = __builtin_amdgcn_mfma_f32_32x32x16_bf16(pa3, PK(l3, h3), od, 0, 0, 0);
#undef PK
}
__device__ __forceinline__ void pv_d0(f32x16* o, int vb, bf16x8 pa0, bf16x8 pa1, bf16x8 pa2, bf16x8 pa3) {
  pv_one<0>(o[0], vb, pa0, pa1, pa2, pa3); pv_one<1>(o[1], vb, pa0, pa1, pa2, pa3); pv_one<2>(o[2], vb, pa0, pa1, pa2, pa3); pv_one<3>(o[3], vb, pa0, pa1, pa2, pa3);
}

template <int ND0, int LDQ, int LDK, int LDO>
__device__ __forceinline__ void attn_unit(const bf16_t* __restrict__ Qb, const bf16_t* __restrict__ Kh, const bf16_t* __restrict__ Vh, bf16_t* __restrict__ Ob,
                                          int seq, int kofs, float C, float thr_raw, char* lds, int mode, const float* sg, float lam, float gscale) {
  const int tid = tid_l(), wid = tid >> 6, lane = tid & 63, r32 = lane & 31, hi = lane >> 5;
  char* V_lds = lds; char* K_lds = lds + 2 * SHM_V;
  float* ws = (float*)(lds + 2 * SHM_V + 2 * SHM_K) + wid * 64; float* li_l = ws; float* al_l = ws + 32;
  constexpr bool PRE = true;
  float m_reg = PRE ? 0.f : -1e30f, l_reg = 0; f32x16 o[4] = {}; bf16x8 qr[ND0];
  const bf16_t* Qw = Qb + (long)(wid * QBLK + r32) * LDQ + hi * 8;
#pragma unroll
  for (int d0 = 0; d0 < ND0; ++d0) qr[d0] = *reinterpret_cast<const bf16x8*>(Qw + d0 * 16);
  const int sr = tid >> 4, sc = (tid & 15) * 8, vst0 = v_st(sr, sc), vst1 = v_st(32 + sr, sc);
  const int vb0 = (int)(uintptr_t)V_lds + v_rd_base(lane);
  bf16x8 vs0a, vs1a, ks0a, ks1a = {}, vs0b, vs1b, ks0b, ks1b = {};
  const int kr = tid >> 3, kcb = kofs + (tid & 7) * 16;
#define KLOAD(dst0, dst1, k0) do { if constexpr (ND0 == 4) { dst0 = *reinterpret_cast<const bf16x8*>(&Kh[(long)((k0) + kr) * LDK + (kcb >> 1)]); } \
    else { dst0 = *reinterpret_cast<const bf16x8*>(&Kh[(long)((k0) + sr) * LDK + sc]); dst1 = *reinterpret_cast<const bf16x8*>(&Kh[(long)((k0) + 32 + sr) * LDK + sc]); } } while (0)
#define KWRITE(b, src0, src1) do { if constexpr (ND0 == 4) { *(bf16x8*)(K_lds + (b) * SHM_K + KSWZ(kr, kcb)) = src0; } \
    else { int kc = sc * 2; *(bf16x8*)(K_lds + (b) * SHM_K + KSWZ(sr, kc)) = src0; *(bf16x8*)(K_lds + (b) * SHM_K + KSWZ(32 + sr, kc)) = src1; } } while (0)
#define SLOAD_A(k0) do { vs0a = *reinterpret_cast<const bf16x8*>(&Vh[(long)((k0) + sr) * LDK + sc]); vs1a = *reinterpret_cast<const bf16x8*>(&Vh[(long)((k0) + 32 + sr) * LDK + sc]); KLOAD(ks0a, ks1a, k0); } while (0)
#define SLOAD_B(k0) do { vs0b = *reinterpret_cast<const bf16x8*>(&Vh[(long)((k0) + sr) * LDK + sc]); vs1b = *reinterpret_cast<const bf16x8*>(&Vh[(long)((k0) + 32 + sr) * LDK + sc]); KLOAD(ks0b, ks1b, k0); } while (0)
#define SWRITE_A(b) do { *(bf16x8*)(V_lds + (b) * SHM_V + vst0) = vs0a; *(bf16x8*)(V_lds + (b) * SHM_V + vst1) = vs1a; KWRITE(b, ks0a, ks1a); } while (0)
#define SWRITE_B(b) do { *(bf16x8*)(V_lds + (b) * SHM_V + vst0) = vs0b; *(bf16x8*)(V_lds + (b) * SHM_V + vst1) = vs1b; KWRITE(b, ks0b, ks1b); } while (0)
#define VWRITE_A(b) do { *(bf16x8*)(V_lds + (b) * SHM_V + vst0) = vs0a; *(bf16x8*)(V_lds + (b) * SHM_V + vst1) = vs1a; } while (0)
#define VWRITE_B(b) do { *(bf16x8*)(V_lds + (b) * SHM_V + vst0) = vs0b; *(bf16x8*)(V_lds + (b) * SHM_V + vst1) = vs1b; } while (0)
#define SWAIT() do { if constexpr (ND0 == 4) asm volatile("s_waitcnt vmcnt(3)" ::: "memory"); else asm volatile("s_waitcnt vmcnt(4)" ::: "memory"); } while (0)
#define PSM(P0, P1, MN, AL) do { if constexpr (PRE) partialSM_pre(P0, P1, m_reg, AL, 11.541560327111707f); else partialSM(P0, P1, m_reg, MN, AL, C, thr_raw); } while (0)
#define RESC(a) do { if (__any((a) < 1.f)) { if (hi == 0) al_l[r32] = (a); asm volatile("s_waitcnt lgkmcnt(0)" ::: "memory"); \
    _Pragma("unroll") for (int d = 0; d < 4; ++d) _Pragma("unroll") for (int r = 0; r < 16; ++r) o[d][r] *= al_l[crow(r, hi)]; } } while (0)
  f32x16 pA0, pA1, pB0, pB1; float mnA, mnB, alA, alB; bf16x8 pa0, pa1, pa2, pa3; const int NT = seq / KVBLK;
  const char* Kq0 = K_lds + kofs; const char* Kq1 = K_lds + SHM_K + kofs;
  SLOAD_A(0); asm volatile("s_waitcnt vmcnt(0)" ::: "memory"); SWRITE_A(0); __syncthreads();
  qkt<ND0>(pA0, pA1, Kq0, qr, r32, hi); PSM(pA0, pA1, mnA, alA);
  SLOAD_B(KVBLK); if (2 < NT) SLOAD_A(2 * KVBLK);
  SWAIT(); SWRITE_B(1); __syncthreads();
  for (int j = 1; j + 1 < NT; j += 2) {
    SBAR(); qkt<ND0>(pB0, pB1, Kq1, qr, r32, hi);
    finishSM(pA0, pA1, alA, l_reg, pa0, pa1, pa2, pa3); SBAR();
    SLOAD_B((j + 2) * KVBLK); SBAR();
    pv_d0(o, vb0, pa0, pa1, pa2, pa3); KWRITE(0, ks0a, ks1a); PSM(pB0, pB1, mnB, alB);
    __syncthreads(); SWAIT(); VWRITE_A(0);
    RESC(alB); __syncthreads();
    SBAR(); qkt<ND0>(pA0, pA1, Kq0, qr, r32, hi);
    finishSM(pB0, pB1, alB, l_reg, pa0, pa1, pa2, pa3); SBAR();
    if (j + 3 < NT) SLOAD_A((j + 3) * KVBLK); SBAR();
    pv_d0(o, vb0 + (int)SHM_V, pa0, pa1, pa2, pa3); KWRITE(1, ks0b, ks1b); PSM(pA0, pA1, mnA, alA);
    __syncthreads(); SWAIT(); VWRITE_B(1);
    RESC(alA); __syncthreads();
  }
  SBAR(); qkt<ND0>(pB0, pB1, Kq1, qr, r32, hi);
  finishSM(pA0, pA1, alA, l_reg, pa0, pa1, pa2, pa3); SBAR();
  pv_d0(o, vb0, pa0, pa1, pa2, pa3); PSM(pB0, pB1, mnB, alB);
  __syncthreads(); RESC(alB);
  finishSM(pB0, pB1, alB, l_reg, pa0, pa1, pa2, pa3); SBAR();
  pv_d0(o, vb0 + (int)SHM_V, pa0, pa1, pa2, pa3);
  if (hi == 0) li_l[r32] = l_reg; asm volatile("s_waitcnt lgkmcnt(0)" ::: "memory");
  float rli[16];
#pragma unroll
  for (int r = 0; r < 16; ++r) rli[r] = __builtin_amdgcn_rcpf(li_l[crow(r, hi)]);
  __syncthreads();
  bf16_t* stg = (bf16_t*)(lds + (mode == 1 ? 69632 : 0) + wid * 8192);
#pragma unroll
  for (int r = 0; r < 16; ++r) { const int orow = crow(r, hi);
#pragma unroll
    for (int d0 = 0; d0 < 4; ++d0) stg[orow * 128 + d0 * 32 + r32] = (bf16_t)f2bf(o[d0][r] * rli[r]); }
  asm volatile("s_waitcnt lgkmcnt(0)" ::: "memory");
  bf16_t* Ow = Ob + (long)(wid * QBLK) * LDO;
  if (mode == 0) {
#pragma unroll
    for (int i = 0; i < 8; ++i) { const int row = i * 4 + (lane >> 4), ch = lane & 15; const u32x4 v = *(const u32x4*)(stg + row * 128 + ch * 8); *(u32x4*)(Ow + (long)row * LDO + ch * 8) = v; }
  } else if (mode == 2) {
    const bf16_t* st1 = (const bf16_t*)(lds + 69632 + wid * 8192); const int ch = lane & 15;
    const f32x4 g0 = *(const f32x4*)(sg + ch * 8) * gscale, g1 = *(const f32x4*)(sg + ch * 8 + 4) * gscale;
#pragma unroll
    for (int i = 0; i < 8; ++i) { const int row = i * 4 + (lane >> 4); const u32x4 w2 = *(const u32x4*)(stg + row * 128 + ch * 8), w1 = *(const u32x4*)(st1 + row * 128 + ch * 8);
      float d[8] = {bflo(w1.x) - lam * bflo(w2.x), bfhi(w1.x) - lam * bfhi(w2.x), bflo(w1.y) - lam * bflo(w2.y), bfhi(w1.y) - lam * bfhi(w2.y),
                    bflo(w1.z) - lam * bflo(w2.z), bfhi(w1.z) - lam * bfhi(w2.z), bflo(w1.w) - lam * bflo(w2.w), bfhi(w1.w) - lam * bfhi(w2.w)};
      float ss = 0.f;
#pragma unroll
      for (int e = 0; e < 8; ++e) ss += d[e] * d[e];
      const float rstd = __builtin_amdgcn_rsqf(sum16(ss) * (1.0f / 128.0f) + EPS);
      u32x4 ov; ov.x = cvtpk(d[0] * rstd * g0.x, d[1] * rstd * g0.y); ov.y = cvtpk(d[2] * rstd * g0.z, d[3] * rstd * g0.w);
      ov.z = cvtpk(d[4] * rstd * g1.x, d[5] * rstd * g1.y); ov.w = cvtpk(d[6] * rstd * g1.z, d[7] * rstd * g1.w);
      *(u32x4*)(Ow + (long)row * LDO + ch * 8) = ov; }
  }
  __syncthreads();
#undef SLOAD_A
#undef VWRITE_A
#undef VWRITE_B
#undef PSM
#undef KLOAD
#undef KWRITE
#undef SLOAD_B
#undef SWRITE_A
#undef SWRITE_B
#undef SWAIT
#undef RESC
}
#undef SBAR
}


#define XB_TMO      128
#define XB_XCNT(j)  (256  + 64 * (j))
#define XB_XSUB(j)  (1280 + 64 * (j))
#define XB_XGEN(j)  (2304 + 64 * (j))
#define XB_TOP      3328
#define XB_TOPGEN   3392
#define XCD_BAR_WORDS 3456
#define XB_SPIN_CAP (1u << 18)
__device__ __forceinline__ unsigned xb_ld(unsigned* p)              { return __hip_atomic_load(p, __ATOMIC_RELAXED, __HIP_MEMORY_SCOPE_AGENT); }
__device__ __forceinline__ unsigned xb_add(unsigned* p, unsigned v) { return __hip_atomic_fetch_add(p, v, __ATOMIC_RELAXED, __HIP_MEMORY_SCOPE_AGENT); }
__device__ __forceinline__ unsigned xb_xcc_id() { return (unsigned)__builtin_amdgcn_s_getreg((3 << 11) | 20) & 0xFu; }
#define XB_SPIN(cond, bar) do { unsigned _sp = 0; while (cond) { __builtin_amdgcn_s_sleep(1); \
    if ((++_sp & 255u) == 0u) { if (xb_ld(&(bar)[XB_TMO])) break; if (_sp > XB_SPIN_CAP) { atomicAdd(&(bar)[XB_TMO], 1u); break; } } } } while (0)
__device__ __forceinline__ void xcd_barrier_complete(unsigned* bar, unsigned x, unsigned& nloc, unsigned& nx) {
    const unsigned G = gridDim.x * gridDim.y * gridDim.z;
    unsigned sum, cnt, mine, sp = 0u;
    for (;;) {
        sum = 0u; cnt = 0u; mine = 0u;
#pragma unroll
        for (unsigned j = 0; j < 16; ++j) { const unsigned c = xb_ld(&bar[XB_XCNT(j)]); sum += c; cnt += (c > 0u) ? 1u : 0u; mine = (j == x) ? c : mine; }
        if (sum == G) break;
        __builtin_amdgcn_s_sleep(1);
        if ((++sp & 255u) == 0u) { if (xb_ld(&bar[XB_TMO])) break; if (sp > XB_SPIN_CAP) { atomicAdd(&bar[XB_TMO], 1u); break; } }
    }
    nloc = mine > 0u ? mine : 1u; nx = cnt > 0u ? cnt : 1u;
}
__device__ __forceinline__ void xcd_barrier(unsigned* bar, volatile LAS unsigned* st) {
    asm volatile("s_waitcnt vmcnt(0)" ::: "memory");
    __syncthreads();
    if (threadIdx.x == 0) {
        const unsigned x = xb_xcc_id();
        __builtin_amdgcn_s_waitcnt(0);
        unsigned nloc = st[0], nx = st[1];
        if (nloc == 0u) { xcd_barrier_complete(bar, x, nloc, nx); st[0] = nloc; st[1] = nx; }
        const unsigned old = xb_add(&bar[XB_XSUB(x)], 1u);
        const unsigned gen = old / nloc;
        if (old + 1u == (gen + 1u) * nloc) {
            __builtin_amdgcn_fence(__ATOMIC_RELEASE, "agent");
            asm volatile("s_waitcnt vmcnt(0)" ::: "memory");
            const unsigned og = xb_add(&bar[XB_TOP], 1u);
            const unsigned tg = og / nx;
            if (og + 1u == (tg + 1u) * nx) xb_add(&bar[XB_TOPGEN], 1u);
            else XB_SPIN(xb_ld(&bar[XB_TOPGEN]) == tg, bar);
            __builtin_amdgcn_fence(__ATOMIC_ACQUIRE, "agent");
            xb_add(&bar[XB_XGEN(x)], 1u);
            asm volatile("s_waitcnt vmcnt(0)" ::: "memory");
        } else {
            XB_SPIN(xb_ld(&bar[XB_XGEN(x)]) == gen, bar);
            __builtin_amdgcn_fence(__ATOMIC_ACQUIRE, "agent");
            asm volatile("s_waitcnt vmcnt(0)" ::: "memory");
        }
    }
    __syncthreads();
}

struct Args { const float* in[21]; float* out; unsigned char* ws; int ph_lo, ph_hi; };

enum Kind { K_PRO = 0, K_NM_MIX, K_G_QKV, K_QKPOST, K_ATTN, K_COMBINE, K_G_OUT, K_NM_FFN, K_G_GU, K_G_DOWN, K_NM_T, K_G_POS, K_G_CH, K_FINAL };
constexpr int N_PHASES = 31;
__device__ __forceinline__ void decode_phase(int ph, int& layer, int& kind) {
    if (ph == 0) { layer = 0; kind = K_PRO; return; }
    if (ph == N_PHASES - 1) { layer = 3; kind = K_FINAL; return; }
    int p = ph - 1;
    if (p < 7) { layer = 0; kind = (p < 2) ? K_NM_MIX + p : (p == 2) ? K_ATTN : K_G_OUT + (p - 3); return; } p -= 7;
    if (p < 8) { layer = 1; kind = (p < 4) ? K_NM_MIX + p : K_NM_MIX + p + 1; return; } p -= 8;
    if (p < 7) { layer = 2; kind = (p == 0) ? K_NM_T : (p == 1) ? K_G_POS : (p == 2) ? K_G_CH : K_G_OUT + (p - 3); return; } p -= 7;
    layer = 3; kind = (p < 2) ? K_NM_MIX + p : (p == 2) ? K_ATTN : K_G_OUT + (p - 3);
}

__device__ __forceinline__ void transpose_item(const float* W, int K, int N, bf16_t* WT, int k0, int n0, int drow0, LAS float* scr, int lane) {
    float tv[32];
#pragma unroll
    for (int i = 0; i < 32; ++i) tv[i] = W[(size_t)(k0 + 2 * i + (lane >> 5)) * N + n0 + (lane & 31)];
#pragma unroll
    for (int i = 0; i < 32; ++i) scr[(2 * i + (lane >> 5)) * 33 + (lane & 31)] = tv[i];
    asm volatile("s_waitcnt lgkmcnt(0)" ::: "memory");
    const int c = lane & 7;
#pragma unroll
    for (int j = 0; j < 4; ++j) { const int n = (lane >> 3) + 8 * j; const LAS float* s = scr + (8 * c) * 33 + n;
        u32x4 o; o.x = cvt_pk_bf16(s[0 * 33], s[1 * 33]); o.y = cvt_pk_bf16(s[2 * 33], s[3 * 33]); o.z = cvt_pk_bf16(s[4 * 33], s[5 * 33]); o.w = cvt_pk_bf16(s[6 * 33], s[7 * 33]);
        *(u32x4*)(WT + (size_t)(drow0 + n) * K + k0 + 8 * c) = o; }
    asm volatile("s_waitcnt lgkmcnt(0)" ::: "memory");
}
__device__ __forceinline__ void transpose_matrix(const float* W, int K, int N, bf16_t* WT, bool perm_gu, int& itbase, int gw, int NGW, LAS float* scr, int lane) {
    const int nblk = N / 32, nitems = (K / 64) * nblk;
    int first = (gw - itbase % NGW + NGW) % NGW;
    for (int it = first; it < nitems; it += NGW) {
        const int kb = it / nblk, nb = it - kb * nblk, n0 = nb * 32; int drow0 = n0;
        if (perm_gu) { drow0 = (n0 < DFF) ? (n0 / 128) * 256 + (n0 % 128) : ((n0 - DFF) / 128) * 256 + 128 + ((n0 - DFF) % 128); }
        transpose_item(W, K, N, WT, kb * 64, n0, drow0, scr, lane);
    }
    itbase += nitems;
}

__global__ void __launch_bounds__(512, 2) fwd_megakernel(Args args) {
    extern __shared__ __attribute__((aligned(16))) unsigned char lds_raw[];
    LAS unsigned char* lds = (LAS unsigned char*)lds_raw;
    cg::grid_group grid = cg::this_grid();
    typedef __attribute__((address_space(4))) const Args* KArgsPtr;
    volatile LAS unsigned* bar_st = (volatile LAS unsigned*)(lds + LDS_BYTES - 64);
    unsigned* bar_words = (unsigned*)(args.ws + WS_BAR);
    if (threadIdx.x < 2) bar_st[threadIdx.x] = 0u;
    __syncthreads();
    if (threadIdx.x == 0) (void)xb_add(&bar_words[XB_XCNT(xb_xcc_id())], 1u);

    for (int sl_ = args.ph_lo; sl_ < args.ph_hi; ++sl_) {
#ifdef PROBE_MASK
        const int ph = sl_ >> 1; { int l_, k_; decode_phase(ph, l_, k_); if ((sl_ & 1) && !((PROBE_MASK >> k_) & 1)) continue; }
#else
        const int ph = sl_;
#endif
        int G = gridDim.x, bx = blockIdx.x; asm volatile("" : "+s"(G), "+s"(bx));
        const int NGW = G * 8, NGT = G * 512;
        const int tid = tid_l(), lane = tid & 63, wave = __builtin_amdgcn_readfirstlane(tid >> 6);
        const int gw = bx * 8 + wave, gtid = bx * 512 + tid;
        KArgsPtr ka = (KArgsPtr)__builtin_amdgcn_kernarg_segment_ptr(); asm volatile("" : "+s"(ka));
#define AIN(i) (ka->in[i])
        unsigned char* ws = ka->ws;
        const float* x_in = AIN(0); const float* c_in = AIN(1); const float* ctx_in = AIN(2); const float* cctx_in = AIN(3);
        float* modv = (float*)(ws + WS_MODV); float* ropeA = (float*)(ws + WS_ROPEA); float* ropeB = (float*)(ws + WS_ROPEB);
        float* xc_ws = (float*)(ws + WS_XC); float* xl_ws = ka->out;
        bf16_t* R1 = (bf16_t*)(ws + WS_R1); bf16_t* R2 = (bf16_t*)(ws + WS_R2); bf16_t* R3 = (bf16_t*)(ws + WS_R3);
        int layer, kind; decode_phase(ph, layer, kind);

        const int mixer = layer % 3, mj = layer / 3;
        const float* xl_cur = (layer == 0 && kind <= K_G_OUT) ? x_in : xl_ws;
        const float* xc_cur = xc_ws;
        const bool last = (layer == 3);
        const bool fuse_ok = (G == 256);
        if (fuse_ok && (kind == K_FINAL || (kind == K_NM_FFN && last))) continue;
        const float* modl = modv + (size_t)layer * 9 * 6144;
        pg8::Gemm gd{}, gd2{}; pg8::Order gS{}, gS2{}; pg8::EpiStore eS{}; pg8::EpiResid eR{}; int gk = 0, gk2 = 0; float* part2 = nullptr;
        switch (kind) {
        case K_PRO: {
            LAS float* scr = (LAS float*)(lds + wave * 8704);
            int itbase = 0;
            for (int l = 0; l < 2; ++l) transpose_matrix(AIN(10) + (size_t)l * 1024 * 3072, 1024, 3072, (bf16_t*)(ws + WS_WQKVA) + (size_t)l * 3072 * 1024, false, itbase, gw, NGW, scr, lane);
            for (int l = 0; l < 2; ++l) transpose_matrix(AIN(13) + (size_t)l * 1024 * 1024, 1024, 1024, (bf16_t*)(ws + WS_WOA) + (size_t)l * 1024 * 1024, false, itbase, gw, NGW, scr, lane);
            transpose_matrix(AIN(14), 1024, 1536, (bf16_t*)(ws + WS_WQKVB), false, itbase, gw, NGW, scr, lane);
            transpose_matrix(AIN(17), 1024, 1024, (bf16_t*)(ws + WS_WOB), false, itbase, gw, NGW, scr, lane);
            transpose_matrix(AIN(18), 1024, 1024, (bf16_t*)(ws + WS_WOC), false, itbase, gw, NGW, scr, lane);
            for (int l = 0; l < 4; ++l) transpose_matrix(AIN(8) + (size_t)l * 1024 * 5632, 1024, 5632, (bf16_t*)(ws + WS_WGU) + (size_t)l * 5632 * 1024, true, itbase, gw, NGW, scr, lane);
            for (int l = 0; l < 4; ++l) transpose_matrix(AIN(9) + (size_t)l * 2816 * 1024, 2816, 1024, (bf16_t*)(ws + WS_WDN) + (size_t)l * 1024 * 2816, false, itbase, gw, NGW, scr, lane);
            LAS float* sl = (LAS float*)(lds + 69632);
            LAS float* part = (LAS float*)(lds + 69632 + 36864);
            for (int i = tid; i < 9 * 1024; i += 512) { const int mi = i >> 10, k = i & 1023; const float v = (mi < 8) ? c_in[mi * 1024 + k] : cctx_in[k]; sl[i] = silu_f(v); }
            __syncthreads();
            for (int it = bx; it < 4 * 96; it += G) {
                const int l = it / 96, n0 = (it % 96) * 64;
                const float* W = AIN(4) + (size_t)l * 1024 * 6144 + n0 + lane;
                float a[9];
#pragma unroll
                for (int mi = 0; mi < 9; ++mi) a[mi] = 0.f;
                for (int k0 = wave * 128; k0 < wave * 128 + 128; k0 += 16) { float wv[16];
#pragma unroll
                    for (int kk = 0; kk < 16; ++kk) wv[kk] = W[(size_t)(k0 + kk) * 6144];
#pragma unroll
                    for (int kk = 0; kk < 16; ++kk)
#pragma unroll
                        for (int mi = 0; mi < 9; ++mi) a[mi] += sl[mi * 1024 + k0 + kk] * wv[kk]; }
#pragma unroll
                for (int mi = 0; mi < 9; ++mi) part[(wave * 9 + mi) * 64 + lane] = a[mi];
                __syncthreads();
                for (int i = tid; i < 576; i += 512) { const int mi = i >> 6, n = i & 63; float s = 0.f;
#pragma unroll
                    for (int w = 0; w < 8; ++w) s += part[(w * 9 + mi) * 64 + n];
                    modv[((size_t)l * 9 + mi) * 6144 + n0 + n] = s + AIN(5)[l * 6144 + n0 + n]; }
                __syncthreads();
            }
            for (int i = gtid; i < NB * CTXL * DM / 4; i += NGT) ((f32x4*)xc_ws)[i] = ((const f32x4*)ctx_in)[i];
            for (int i = gtid; i < 64 * 16; i += NGT) { const int pos = i >> 4, f = i & 15; const float inv = __builtin_amdgcn_exp2f(-(float)f * (13.287712379549449f / 16.0f));
                float tr = (float)pos * inv * 0.15915494309189535f; tr -= floorf(tr); ropeA[2 * i] = __builtin_amdgcn_cosf(tr); ropeA[2 * i + 1] = __builtin_amdgcn_sinf(tr); }
            for (int i = gtid; i < 64 * 32; i += NGT) { const int pos = i >> 5, f = i & 31; const float inv = __builtin_amdgcn_exp2f(-(float)f * (13.287712379549449f / 32.0f));
                float tr = (float)pos * inv * 0.15915494309189535f; tr -= floorf(tr); ropeB[2 * i] = __builtin_amdgcn_cosf(tr); ropeB[2 * i + 1] = __builtin_amdgcn_sinf(tr); }
            bf16_t* csctx = (bf16_t*)(ws + WS_CSCTX); bf16_t* dc = (bf16_t*)(ws + WS_DC);
            for (int i = gtid; i < 256 * 256; i += NGT) { const int r = i >> 8, n = i & 255, half = (r >> 7) & 1; int k = r & 127; int hf = half; if (half && k == 0) { k = 128; hf = 0; }
                const float tr = (float)((k * n) & 255) * (1.0f / 256.0f); const float v = (hf ? __builtin_amdgcn_sinf(tr) : __builtin_amdgcn_cosf(tr)) * 0.0625f; csctx[i] = (bf16_t)f2bf(v); }
            for (int i = gtid; i < 256 * 512; i += NGT) { const int j = i >> 9, col = i & 511, cs = col >> 8, cch = col & 255;
                const float tr = (float)((cch * j) & 255) * (1.0f / 256.0f); const float v = (cs ? -__builtin_amdgcn_sinf(tr) : __builtin_amdgcn_cosf(tr)) * 0.0625f; dc[i] = (bf16_t)f2bf(v); }
        } break;
        case K_NM_MIX: case K_NM_FFN: {
            const float* ln = (kind == K_NM_MIX ? AIN(6) : AIN(7)) + layer * 1024; const int chunk = (kind == K_NM_MIX) ? 0 : 3;
            if (!(last && kind == K_NM_FFN)) {
                int pS = 0; const float* pP = nullptr; const float* pg = nullptr; const float* pb = nullptr;
                if (kind == K_NM_FFN) { pS = 4; pP = (const float*)R1; pg = modl + 8 * 6144 + 2 * 1024; pb = (mixer == 2) ? AIN(19) : nullptr; }
                else if (layer == 1 || layer == 3) { pS = 11; pP = (const float*)R2; pg = modv + (size_t)(layer - 1) * 9 * 6144 + 8 * 6144 + 5 * 1024; }
                const float* sh = modl + 8 * 6144 + chunk * 1024; const float* sc = sh + 1024;
                for (int cr = gw; cr < NB * CTXL; cr += NGW) {
                    f32x4* xr = (f32x4*)(xc_ws + (size_t)cr * DM); f32x4 v[4];
#pragma unroll
                    for (int j = 0; j < 4; ++j) v[j] = xr[lane + 64 * j];
                    if (pS) { f32x4 a4[4];
#pragma unroll
                        for (int j = 0; j < 4; ++j) a4[j] = pb ? ((const f32x4*)pb)[lane + 64 * j] : (f32x4){0.f, 0.f, 0.f, 0.f};
                        for (int s = 0; s < pS; ++s) { const f32x4* pr = (const f32x4*)(pP + ((size_t)s * (NB * CTXL) + cr) * DM);
#pragma unroll
                            for (int j = 0; j < 4; ++j) a4[j] += pr[lane + 64 * j]; }
#pragma unroll
                        for (int j = 0; j < 4; ++j) { v[j] += ((const f32x4*)pg)[lane + 64 * j] * a4[j]; xr[lane + 64 * j] = v[j]; } }
                    float ss = 0.f;
#pragma unroll
                    for (int j = 0; j < 4; ++j) ss += (v[j].x * v[j].x + v[j].y * v[j].y) + (v[j].z * v[j].z + v[j].w * v[j].w);
                    const float rstd = __builtin_amdgcn_rsqf(wave_sum(ss) * (1.0f / DM) + EPS);
                    u32x2* o8 = (u32x2*)(R3 + ((size_t)(cr >> 8) * RPB + (cr & 255)) * DM) + lane;
#pragma unroll
                    for (int j = 0; j < 4; ++j) { const f32x4 y = v[j] * rstd * (((const f32x4*)ln)[lane + 64 * j] * (((const f32x4*)sc)[lane + 64 * j] + 1.0f)) + ((const f32x4*)sh)[lane + 64 * j];
                        u32x2 w; w.x = cvt_pk_bf16(y.x, y.y); w.y = cvt_pk_bf16(y.z, y.w); o8[64 * j] = w; }
                }
            }
            const bool nm_fused = fuse_ok && (kind == K_NM_FFN || layer == 1 || layer == 3);
            const int NLAT = nm_fused ? 0 : NB * SEQ, rpw = (((NB * SEQ + NGW - 1) / NGW) + 3) & ~3, r0 = gw * rpw, r1 = (r0 + rpw < NLAT) ? r0 + rpw : NLAT;
            f32x4 v[4][4] = {}, vn[4][4] = {}, Am[4] = {}, Bm[4] = {}; int cur_mi = -1;
#pragma unroll
            for (int q = 0; q < 4; ++q) if (r0 + q < r1) { const float* xr = xl_cur + (size_t)(r0 + q) * DM;
#pragma unroll
                for (int j = 0; j < 4; ++j) v[q][j] = ((const f32x4*)xr)[lane + 64 * j]; }
            for (int row = r0; row < r1; row += 4) {
#pragma unroll
                for (int q = 0; q < 4; ++q) if (row + 4 + q < r1) { const float* xr = xl_cur + (size_t)(row + 4 + q) * DM;
#pragma unroll
                    for (int j = 0; j < 4; ++j) vn[q][j] = ((const f32x4*)xr)[lane + 64 * j]; }
                const int mi = row >> 12;
                if (mi != cur_mi) { cur_mi = mi; const float* sh = modl + mi * 6144 + chunk * 1024; const float* sc = sh + 1024;
#pragma unroll
                    for (int j = 0; j < 4; ++j) { Am[j] = ((const f32x4*)ln)[lane + 64 * j] * (((const f32x4*)sc)[lane + 64 * j] + 1.0f); Bm[j] = ((const f32x4*)sh)[lane + 64 * j]; } }
                float rstd[4];
#pragma unroll
                for (int q = 0; q < 4; ++q) { float ss = 0.f;
#pragma unroll
                    for (int j = 0; j < 4; ++j) ss += (v[q][j].x * v[q][j].x + v[q][j].y * v[q][j].y) + (v[q][j].z * v[q][j].z + v[q][j].w * v[q][j].w);
                    rstd[q] = __builtin_amdgcn_rsqf(wave_sum(ss) * (1.0f / DM) + EPS); }
#pragma unroll
                for (int q = 0; q < 4; ++q) if (row + q < r1) { u32x2* o8 = (u32x2*)(R3 + ((size_t)mi * RPB + CTXL + ((row + q) & 4095)) * DM) + lane;
#pragma unroll
                    for (int j = 0; j < 4; ++j) { const f32x4 y = v[q][j] * rstd[q] * Am[j] + Bm[j]; u32x2 w; w.x = cvt_pk_bf16(y.x, y.y); w.y = cvt_pk_bf16(y.z, y.w); o8[64 * j] = w; } }
#pragma unroll
                for (int q = 0; q < 4; ++q)
#pragma unroll
                    for (int j = 0; j < 4; ++j) v[q][j] = vn[q][j];
            }
        } break;
        case K_NM_T: {
            const float* ln = AIN(6) + layer * 1024;
            LAS bf16_t* tile = (LAS bf16_t*)lds;
            bf16_t* HTl = R3; bf16_t* HTc = (bf16_t*)((unsigned char*)R3 + R3_HTC_OFF);
            for (int it = bx; it < MROWS / 64; it += G) {
                const int row0 = it * 64, b = row0 / RPB, t0 = row0 - b * RPB; const bool isc = t0 < CTXL;
                const float* sh = modl + (isc ? 8 : b) * 6144; const float* sc = sh + 1024;
                float Ac[16], Bc[16], v[16], vn[16] = {};
#pragma unroll
                for (int j = 0; j < 16; ++j) { const int col = lane + 64 * j; Ac[j] = ln[col] * (sc[col] + 1.0f); Bc[j] = sh[col]; }
                { const int t = t0 + wave * 8; const float* xr = isc ? xc_cur + (size_t)(b * CTXL + t) * DM : xl_cur + (size_t)(b * SEQ + t - CTXL) * DM;
#pragma unroll
                  for (int j = 0; j < 16; ++j) v[j] = xr[lane + 64 * j]; }
                const float* pgT = modv + (size_t)(layer - 1) * 9 * 6144 + 8 * 6144 + 5 * 1024;
                for (int i = 0; i < 8; ++i) { const int rr = wave * 8 + i;
                    if (isc) { const int cr = b * CTXL + t0 + rr; const float* p0 = (const float*)R2 + (size_t)cr * DM; const float* p1 = p0 + (size_t)NB * CTXL * DM; float* xw = xc_ws + (size_t)cr * DM;
#pragma unroll
                        for (int j = 0; j < 16; ++j) { const int col = lane + 64 * j; v[j] += pgT[col] * (p0[col] + p1[col]); xw[col] = v[j]; } }
                    if (i + 1 < 8) { const int t = t0 + rr + 1; const float* xr = isc ? xc_cur + (size_t)(b * CTXL + t) * DM : xl_cur + (size_t)(b * SEQ + t - CTXL) * DM;
#pragma unroll
                        for (int j = 0; j < 16; ++j) vn[j] = xr[lane + 64 * j]; }
                    float ss = 0.f;
#pragma unroll
                    for (int j = 0; j < 16; ++j) ss += v[j] * v[j];
                    const float rstd = __builtin_amdgcn_rsqf(wave_sum(ss) * (1.0f / DM) + EPS);
#pragma unroll
                    for (int j = 0; j < 16; ++j) { const float y = v[j] * rstd * Ac[j] + Bc[j]; tile[(lane + 64 * j) * 66 + rr] = (bf16_t)f2bf(y); }
#pragma unroll
                    for (int j = 0; j < 16; ++j) v[j] = vn[j]; }
                __syncthreads();
                for (int idx = tid; idx < 1024 * 32; idx += 512) { const int cch = idx >> 5, tp = idx & 31; const unsigned w = *(const LAS unsigned*)(tile + cch * 66 + 2 * tp);
                    bf16_t* dst = isc ? HTc + ((size_t)(b * 1024 + cch) * CTXL + t0 + 2 * tp) : HTl + ((size_t)(b * 1024 + cch) * SEQ + (t0 - CTXL) + 2 * tp);
                    *(unsigned*)dst = w; }
                __syncthreads();
            }
            bf16_t* CS = (bf16_t*)((unsigned char*)R2 + R2_CS_OFF);
            for (int idx = gtid; idx < 4096 * 512; idx += NGT) { const int r = idx >> 9, n0 = (idx & 511) * 8; int half = (r >> 7) & 1, k = (r >> 8) * 128 + (r & 127); if (half && k == 0) { k = 2048; half = 0; }
                float vv[8];
#pragma unroll
                for (int e = 0; e < 8; ++e) { const float tr = (float)((k * (n0 + e)) & 4095) * (1.0f / 4096.0f); vv[e] = (half ? __builtin_amdgcn_sinf(tr) : __builtin_amdgcn_cosf(tr)) * 0.015625f; }
                u32x4 w; w.x = cvt_pk_bf16(vv[0], vv[1]); w.y = cvt_pk_bf16(vv[2], vv[3]); w.z = cvt_pk_bf16(vv[4], vv[5]); w.w = cvt_pk_bf16(vv[6], vv[7]);
                *(u32x4*)(CS + (size_t)r * 4096 + n0) = w; }
        } break;
        case K_G_QKV: {
            if (mixer == 0) { gd = pg8::Gemm{R3, (const bf16_t*)(ws + WS_WQKVA) + (size_t)mj * 3072 * 1024, 1024, 1024, 1024, 0, 0}; gS.init(MROWS / 256, 12, 1, G, bx); eS = pg8::EpiStore{R1, 3072, 0, ropeA, 8}; }
            else { gd = pg8::Gemm{R3, (const bf16_t*)(ws + WS_WQKVB), 1024, 1024, 1024, 0, 0}; gS.init(MROWS / 256, 6, 1, G, bx); eS = pg8::EpiStore{R1, 1536, 0, nullptr, 0}; }
            gk = 1;
        } break;
        case K_G_CH: {
            gS.init(MROWS / 256, 1, 4, G, bx);
            gd = pg8::Gemm{R1, (const bf16_t*)(ws + WS_DC), 2048, 512, 512, 512 * 2, 0};
            eS = pg8::EpiStore{R2, 1024, 256, nullptr, 0}; gk = 1;
        } break;
        case K_G_POS: gk = 4; break;
        case K_G_OUT: {
            const bf16_t* A = (mixer == 0) ? R3 : R2;
            const bf16_t* W = (mixer == 0) ? (const bf16_t*)(ws + WS_WOA) + (size_t)mj * 1024 * 1024 : (mixer == 1) ? (const bf16_t*)(ws + WS_WOB) : (const bf16_t*)(ws + WS_WOC);
            gS.init(128, 4, 1, G, bx, 2);
            gd = pg8::Gemm{A, W, 1024, 1024, 1024, 0, 0};
            eR = pg8::EpiResid{xl_cur, xc_cur, xl_ws, xc_ws, modl + 2 * 1024, (mixer == 2) ? AIN(19) : nullptr, nullptr,
                               fuse_ok ? 1 : 0, R3, AIN(7) + layer * 1024, modl + 3 * 1024, (float*)(ws + WS_XBUF), (unsigned*)(ws + WS_CNT) + (size_t)(layer * 2) * 128 * 64, lds + pg8::STAGE_BYTES}; gk = 2;
            if (!last) { gS2.init(8, 4, 4, G, bx, 1); gd2 = pg8::Gemm{A, W, 1024, 1024, 256, 512, 512}; gk2 = 1; part2 = (float*)R1; }
        } break;
        case K_G_GU: {
            if (last) gS.init(128, 22, 1, G, bx, 2); else gS.init(MROWS / 256, 22, 1, G, bx);
            gd = pg8::Gemm{R3, (const bf16_t*)(ws + WS_WGU) + (size_t)layer * 5632 * 1024, 1024, 1024, 1024, 0, 0}; gk = 3;
        } break;
        case K_G_DOWN: {
            const bf16_t* W = (const bf16_t*)(ws + WS_WDN) + (size_t)layer * 1024 * 2816;
            gS.init(128, 4, 1, G, bx, 2);
            gd = pg8::Gemm{R1, W, 2816, 2816, 2816, 0, 0};
            eR = pg8::EpiResid{xl_ws, xc_ws, xl_ws, xc_ws, modl + 5 * 1024, nullptr, nullptr,
                               (!fuse_ok || layer == 1) ? 0 : (last ? 2 : 1), R3, last ? AIN(20) : AIN(6) + (layer + 1) * 1024, modv + (size_t)(layer + 1) * 9 * 6144, (float*)(ws + WS_XBUF),
                               (unsigned*)(ws + WS_CNT) + (size_t)(layer * 2 + 1) * 128 * 64, lds + pg8::STAGE_BYTES}; gk = 2;
            if (layer == 0 || layer == 2) { gS2.init(8, 4, 11, G, bx, 1); gd2 = pg8::Gemm{R1, W, 2816, 2816, 256, 512, 512}; gk2 = 1; part2 = (float*)R2; }
            if (layer == 1) { gS2.init(8, 4, 2, G, bx, 1); gd2 = pg8::Gemm{R1, W, 2816, 2816, 1408, 2816, 2816}; gk2 = 1; part2 = (float*)R2; }
        } break;
        case K_QKPOST: {
            const float* qn = AIN(15); const float* kn = AIN(16);
            const int rpw = (MROWS + NGW - 1) / NGW, r0 = gw * rpw, r1 = (r0 + rpw < MROWS) ? r0 + rpw : MROWS;
            const int wi = (lane & 15) * 8, p0 = (lane & 15) * 4, f0 = p0 & 31;
            const float qsc = 0.088388347648318440f * 1.4426950408889634f;
            const f32x4 gq0 = *(const f32x4*)(qn + wi) * qsc, gq1 = *(const f32x4*)(qn + wi + 4) * qsc, gk0 = *(const f32x4*)(kn + wi), gk1 = *(const f32x4*)(kn + wi + 4);
            for (int row = r0; row < r1; row += 4) {
                u32x4 w[4][3]; f32x4 c0[4], c1[4];
#pragma unroll
                for (int q = 0; q < 4; ++q) { const int rq = (row + q < r1) ? row + q : r1 - 1;
                    const int b = rq / RPB, t = rq - b * RPB; const bool isc = t < CTXL; const int tl = isc ? 0 : t - CTXL, rp = tl >> 6, cp = tl & 63, pos = (p0 < 32) ? rp : cp;
#pragma unroll
                    for (int j = 0; j < 3; ++j) w[q][j] = *(const u32x4*)(R1 + (size_t)rq * 1536 + (j * 64 + lane) * 8);
                    c0[q] = *(const f32x4*)(ropeB + (pos * 32 + f0) * 2); c1[q] = *(const f32x4*)(ropeB + (pos * 32 + f0) * 2 + 4);
                    if (isc) { c0[q] = (f32x4){1.f, 0.f, 1.f, 0.f}; c1[q] = c0[q]; } }
#pragma unroll
                for (int q = 0; q < 4; ++q) if (row + q < r1) { const f32x4 cs0 = c0[q], cs1 = c1[q];
#pragma unroll
                    for (int j = 0; j < 3; ++j) { const int head = (j * 64 + lane) >> 4; const u32x4 ww = w[q][j];
                        float xv[8] = {bflo(ww.x), bfhi(ww.x), bflo(ww.y), bfhi(ww.y), bflo(ww.z), bfhi(ww.z), bflo(ww.w), bfhi(ww.w)};
                        float ss = 0.f;
#pragma unroll
                        for (int e = 0; e < 8; ++e) ss += xv[e] * xv[e];
                        const float rstd = __builtin_amdgcn_rsqf(sum16(ss) * (1.0f / 128.0f) + EPS);
                        const f32x4 g0 = (head < 8) ? gq0 : gk0, g1 = (head < 8) ? gq1 : gk1;
                        const float a0 = xv[0] * rstd * g0.x, a1 = xv[1] * rstd * g0.y, b0 = xv[2] * rstd * g0.z, b1 = xv[3] * rstd * g0.w;
                        const float e0 = xv[4] * rstd * g1.x, e1 = xv[5] * rstd * g1.y, d0 = xv[6] * rstd * g1.z, d1 = xv[7] * rstd * g1.w;
                        u32x4 o; o.x = cvt_pk_bf16(a0 * cs0.x - a1 * cs0.y, a0 * cs0.y + a1 * cs0.x); o.y = cvt_pk_bf16(b0 * cs0.z - b1 * cs0.w, b0 * cs0.w + b1 * cs0.z);
                        o.z = cvt_pk_bf16(e0 * cs1.x - e1 * cs1.y, e0 * cs1.y + e1 * cs1.x); o.w = cvt_pk_bf16(d0 * cs1.z - d1 * cs1.w, d0 * cs1.w + d1 * cs1.z);
                        if (head < 10) *(u32x4*)(R1 + (size_t)(row + q) * 1536 + (j * 64 + lane) * 8) = o; } }
            }
        } break;
        case K_ATTN: {
            char* albs = (char*)lds_raw;
            const bool need_ctx = (layer != 3);
            const int gx = (G % 8 == 0) ? G / 8 : G, xcd = (G % 8 == 0) ? bx % 8 : 0, vl = (G % 8 == 0) ? bx / 8 : bx, nxc = (G % 8 == 0) ? 8 : 1;
            if (mixer == 0) {
                const float C = 0.125f * 1.4426950408889634f, thr = 8.f / 0.125f;
                const float* lv = AIN(11) + mj * 256; const float* sg = AIN(12) + mj * 128;
                const float linit = (layer == 0) ? LAMINIT0 : LAMINIT3;
                const float sa = wave_sum(lv[lane] * lv[64 + lane]), sb = wave_sum(lv[128 + lane] * lv[192 + lane]);
                const float lam = __expf(sa) - __expf(sb) + linit;
                const int per_x = 1024 / nxc, nlat = (per_x - vl + gx - 1) / gx, nctx = need_ctx ? (64 - bx + G - 1) / G : 0;
                for (int i2 = 0; i2 < 2 * (nlat + (nctx > 0 ? nctx : 0)); ++i2) {
                    const int i = i2 >> 1, comp = i2 & 1;
                    int b, h, seq; size_t qrow;
                    if (i < nlat) { const int U = xcd * per_x + vl + i * gx, bh = U >> 4; b = bh >> 3; h = bh & 7; qrow = (size_t)b * RPB + CTXL + (U & 15) * 256; seq = RPB; }
                    else { const int bh = bx + (i - nlat) * G; b = bh >> 3; h = bh & 7; qrow = (size_t)b * RPB; seq = CTXL; }
                    const size_t krow = (size_t)b * RPB;
#ifndef NO_ATTN4
                    att::attn_unit<4, 3072, 3072, 1024>(R1 + qrow * 3072 + h * 128 + comp * 64, R1 + krow * 3072 + 1024 + h * 128, R1 + krow * 3072 + 2048 + h * 128,
                                                        R3 + qrow * 1024 + h * 128, seq, comp * 128, C, thr, albs, 1 + comp, sg, lam, 1.0f - linit);
#endif
                }
            } else {
                const float sc_ = 0.088388347648318440f; const float C = sc_ * 1.4426950408889634f, thr = 8.f / sc_;
                const int per_x = 1024 / nxc, nlat = (per_x - vl + gx - 1) / gx, nctx = need_ctx ? (64 - bx + G - 1) / G : 0;
                for (int i = 0; i < nlat + (nctx > 0 ? nctx : 0); ++i) {
                    int b, qh, kvh, seq; size_t qrow;
                    if (i < nlat) { const int U = xcd * per_x + vl + i * gx, combo = U >> 6, k = U & 63; b = combo >> 1; kvh = combo & 1; qh = kvh * 4 + (k >> 4); qrow = (size_t)b * RPB + CTXL + (k & 15) * 256; seq = RPB; }
                    else { const int U = bx + (i - nlat) * G; b = U >> 3; qh = U & 7; kvh = qh >> 2; qrow = (size_t)b * RPB; seq = CTXL; }
                    const size_t krow = (size_t)b * RPB;
#ifndef NO_ATTN8
                    att::attn_unit<8, 1536, 1536, 1024>(R1 + qrow * 1536 + qh * 128, R1 + krow * 1536 + 1024 + kvh * 128, R1 + krow * 1536 + 1280 + kvh * 128,
                                                        R2 + qrow * 1024 + qh * 128, seq, 0, C, thr, albs, 0, nullptr, 0.f, 0.f);
#endif
                }
            }
        } break;
        case K_COMBINE: {
            const float* lv = AIN(11) + mj * 256; const float* sg = AIN(12) + mj * 128;
            const float linit = (layer == 0) ? LAMINIT0 : LAMINIT3;
            const float sa = wave_sum(lv[lane] * lv[64 + lane]), sb = wave_sum(lv[128 + lane] * lv[192 + lane]);
            const float lam = __expf(sa) - __expf(sb) + linit;
            const int wi = (lane & 15) * 8; const f32x4 g0 = *(const f32x4*)(sg + wi) * (1.0f - linit), g1 = *(const f32x4*)(sg + wi + 4) * (1.0f - linit);
            const int rpw = (MROWS + NGW - 1) / NGW, r0 = gw * rpw, r1 = (r0 + rpw < MROWS) ? r0 + rpw : MROWS;
            u32x4 q1[2] = {}, q2[2] = {}, n1[2] = {}, n2[2] = {};
            if (r0 < r1) {
#pragma unroll
                for (int j = 0; j < 2; ++j) { const int head = (j * 64 + lane) >> 4; q1[j] = *(const u32x4*)(R2 + (size_t)r0 * 2048 + head * 256 + wi); q2[j] = *(const u32x4*)(R2 + (size_t)r0 * 2048 + head * 256 + 128 + wi); } }
            for (int row = r0; row < r1; ++row) {
                if (row + 1 < r1) {
#pragma unroll
                    for (int j = 0; j < 2; ++j) { const int head = (j * 64 + lane) >> 4; n1[j] = *(const u32x4*)(R2 + (size_t)(row + 1) * 2048 + head * 256 + wi); n2[j] = *(const u32x4*)(R2 + (size_t)(row + 1) * 2048 + head * 256 + 128 + wi); } }
                const bool isc = (row % RPB) < CTXL;
                if (!(last && isc)) {
#pragma unroll
                for (int j = 0; j < 2; ++j) { const int head = (j * 64 + lane) >> 4; const u32x4 w1 = q1[j], w2 = q2[j];
                    float d[8] = {bflo(w1.x) - lam * bflo(w2.x), bfhi(w1.x) - lam * bfhi(w2.x), bflo(w1.y) - lam * bflo(w2.y), bfhi(w1.y) - lam * bfhi(w2.y),
                                  bflo(w1.z) - lam * bflo(w2.z), bfhi(w1.z) - lam * bfhi(w2.z), bflo(w1.w) - lam * bflo(w2.w), bfhi(w1.w) - lam * bfhi(w2.w)};
                    float ss = 0.f;
#pragma unroll
                    for (int e = 0; e < 8; ++e) ss += d[e] * d[e];
                    const float rstd = __builtin_amdgcn_rsqf(sum16(ss) * (1.0f / 128.0f) + EPS);
                    u32x4 o; o.x = cvt_pk_bf16(d[0] * rstd * g0.x, d[1] * rstd * g0.y); o.y = cvt_pk_bf16(d[2] * rstd * g0.z, d[3] * rstd * g0.w);
                    o.z = cvt_pk_bf16(d[4] * rstd * g1.x, d[5] * rstd * g1.y); o.w = cvt_pk_bf16(d[6] * rstd * g1.z, d[7] * rstd * g1.w);
                    *(u32x4*)(R3 + (size_t)row * DM + head * 128 + wi) = o; }
                }
#pragma unroll
                for (int j = 0; j < 2; ++j) { q1[j] = n1[j]; q2[j] = n2[j]; }
            }
        } break;
        case K_FINAL: {
            const float* fn = AIN(20);
            const int NLAT = fuse_ok ? 0 : NB * SEQ, rpw = (((NB * SEQ + NGW - 1) / NGW) + 3) & ~3, r0 = gw * rpw, r1 = (r0 + rpw < NLAT) ? r0 + rpw : NLAT;
            f32x4 v[4][4] = {}, vn[4][4] = {}, fw[4];
#pragma unroll
            for (int j = 0; j < 4; ++j) fw[j] = ((const f32x4*)fn)[lane + 64 * j];
#pragma unroll
            for (int q = 0; q < 4; ++q) if (r0 + q < r1) {
#pragma unroll
                for (int j = 0; j < 4; ++j) v[q][j] = ((const f32x4*)(xl_ws + (size_t)(r0 + q) * DM))[lane + 64 * j]; }
            for (int row = r0; row < r1; row += 4) {
#pragma unroll
                for (int q = 0; q < 4; ++q) if (row + 4 + q < r1) {
#pragma unroll
                    for (int j = 0; j < 4; ++j) vn[q][j] = ((const f32x4*)(xl_ws + (size_t)(row + 4 + q) * DM))[lane + 64 * j]; }
                float rstd[4];
#pragma unroll
                for (int q = 0; q < 4; ++q) { float ss = 0.f;
#pragma unroll
                    for (int j = 0; j < 4; ++j) ss += (v[q][j].x * v[q][j].x + v[q][j].y * v[q][j].y) + (v[q][j].z * v[q][j].z + v[q][j].w * v[q][j].w);
                    rstd[q] = __builtin_amdgcn_rsqf(wave_sum(ss) * (1.0f / DM) + EPS); }
#pragma unroll
                for (int q = 0; q < 4; ++q) if (row + q < r1) { f32x4* xr = (f32x4*)(xl_ws + (size_t)(row + q) * DM);
#pragma unroll
                    for (int j = 0; j < 4; ++j) xr[lane + 64 * j] = v[q][j] * rstd[q] * fw[j]; }
#pragma unroll
                for (int q = 0; q < 4; ++q)
#pragma unroll
                    for (int j = 0; j < 4; ++j) v[q][j] = vn[q][j];
            }
        } break;
        default: break;
        }
#ifndef NO_GEMM
        if (gk == 1) pg8::gemm_phase<pg8::EpiStore>(lds, gd, gS, eS);
        else if (gk == 2) {
            for (int it = 0; it < 1 + gk2; ++it) {
                const int rep = (gk2 && bx < 128) ? 1 - it : it;
                const pg8::Gemm g_ = rep ? gd2 : gd; const pg8::Order s_ = rep ? gS2 : gS; pg8::EpiResid e_ = eR; e_.part = rep ? part2 : nullptr;
                pg8::gemm_phase<pg8::EpiResid>(lds, g_, s_, e_);
            }
        }
        else if (gk == 3) { pg8::EpiSwiGLU E{R1}; pg8::gemm_phase<pg8::EpiSwiGLU>(lds, gd, gS, E); }
        else if (gk == 4) {
            for (int rep = 0; rep < 2; ++rep) {
                if (rep == 0) { gS.init(16, 4, 8, G, bx); gd = pg8::Gemm{(const bf16_t*)((unsigned char*)R2 + R2_CS_OFF), R3, 4096, 4096, 4096, 0, (size_t)1024 * 4096 * 2}; }
                else { gS.init(1, 4, 8, G, bx); gd = pg8::Gemm{(const bf16_t*)(ws + WS_CSCTX), (const bf16_t*)((unsigned char*)R3 + R3_HTC_OFF), 256, 256, 256, 0, (size_t)1024 * 256 * 2}; }
                pg8::EpiPosDft E{R1, rep == 0 ? CTXL : 0, rep == 0 ? SEQ : CTXL}; pg8::gemm_phase<pg8::EpiPosDft>(lds, gd, gS, E);
            }
        }
#endif
        if (sl_ + 1 < args.ph_hi) {
            if (MK_PER_PHASE || ka->ph_lo < 0) grid.sync();
            else { unsigned* bw = (unsigned*)(ka->ws + WS_BAR); xcd_barrier(bw, bar_st); }
        }
    }
}

extern "C" void kernel_launch(void* const* d_in, const int* in_sizes, int n_in, void* d_out, int out_size, void* d_ws, size_t ws_size, hipStream_t stream) {
    static int grid = 0;
    if (grid == 0) {
        if (n_in != 21 || in_sizes[0] != NB * SEQ * DM || out_size != NB * SEQ * DM || ws_size < WS_END) {
            fprintf(stderr, "kernel_launch: unexpected shapes: n_in %d in0 %d out %d ws %zu (need >= %zu)\n", n_in, n_in > 0 ? in_sizes[0] : -1, out_size, ws_size, (size_t)WS_END); grid = -1; return; }
        int dev = 0, cus = 0, per_cu = 0;
        if (hipGetDevice(&dev) != hipSuccess || hipDeviceGetAttribute(&cus, hipDeviceAttributeMultiprocessorCount, dev) != hipSuccess) { fprintf(stderr, "kernel_launch: device query failed\n"); grid = -1; return; }
        if (hipFuncSetAttribute((const void*)fwd_megakernel, hipFuncAttributeMaxDynamicSharedMemorySize, LDS_BYTES) != hipSuccess) { fprintf(stderr, "kernel_launch: hipFuncSetAttribute failed\n"); grid = -1; return; }
        if (hipOccupancyMaxActiveBlocksPerMultiprocessor(&per_cu, (const void*)fwd_megakernel, 512, LDS_BYTES) != hipSuccess || per_cu < 1) { fprintf(stderr, "kernel_launch: occupancy query gave %d\n", per_cu); per_cu = 1; }
        (void)hipGetLastError();
        grid = cus * 1;
    }
    if (grid < 0) return;
    if (hipMemsetAsync((char*)d_ws + WS_BAR, 0, 65536 + 8 * 128 * 64 * 4, stream) != hipSuccess) { fprintf(stderr, "kernel_launch: memset of barrier words failed\n"); return; }
    Args a{};
    for (int i = 0; i < 21; ++i) a.in[i] = (const float*)d_in[i];
    a.out = (float*)d_out; a.ws = (unsigned char*)d_ws;
#if MK_PER_PHASE
    for (int ph = 0; ph < N_PHASES; ++ph) {
        a.ph_lo = ph; a.ph_hi = ph + 1; void* kargs[] = {&a};
        hipError_t e = hipLaunchCooperativeKernel((const void*)fwd_megakernel, dim3(grid), dim3(512), kargs, LDS_BYTES, stream);
        if (e != hipSuccess) { fprintf(stderr, "kernel_launch: launch (phase %d) failed: %s (grid %d)\n", ph, hipGetErrorString(e), grid); break; }
    }
#else
#ifdef PROBE_MASK
    a.ph_lo = 0; a.ph_hi = 2 * N_PHASES;
#else
    a.ph_lo = 0; a.ph_hi = N_PHASES;
#endif
    void* kargs[] = {&a};
    hipError_t e = hipLaunchCooperativeKernel((const void*)fwd_megakernel, dim3(grid), dim3(512), kargs, LDS_BYTES, stream);
    if (e != hipSuccess) fprintf(stderr, "kernel_launch: cooperative launch failed: %s (grid %d)\n", hipGetErrorString(e), grid);
#endif
}
```

```cpp
#include <hip/hip_runtime.h>
#include <hip/hip_bf16.h>
#include <hip/hip_cooperative_groups.h>
#include <cstdio>
#include <cstdint>
namespace cg = cooperative_groups;

#ifndef MK_PER_PHASE
#define MK_PER_PHASE 0
#endif

constexpr int NB = 8, SEQ = 4096, DM = 1024, CTXL = 256, RPB = SEQ + CTXL  , MROWS = NB * RPB  ;
constexpr int DFF = 2816, NTILE_B = RPB / 256  ;
constexpr float EPS = 1e-6f;
constexpr float LAMINIT0 = 0.2f, LAMINIT3 = 0.55605820415564054f;

constexpr size_t MiB = 1u << 20;
constexpr size_t WS_MODV = 0;
constexpr size_t WS_ROPEA = 1 * MiB;
constexpr size_t WS_ROPEB = 1 * MiB + 65536;
constexpr size_t WS_CSCTX = 2 * MiB;
constexpr size_t WS_DC = 2 * MiB + 512 * 1024;
constexpr size_t WS_BAR = 3 * MiB;
constexpr size_t WS_CNT = 3 * MiB + 65536;
constexpr size_t WS_XBUF = 3 * MiB + 524288;
constexpr size_t WS_XC = 4 * MiB;
constexpr size_t WS_WQKVA = 12 * MiB;
constexpr size_t WS_WOA = 24 * MiB;
constexpr size_t WS_WQKVB = 28 * MiB;
constexpr size_t WS_WOB = 31 * MiB;
constexpr size_t WS_WOC = 33 * MiB;
constexpr size_t WS_WGU = 35 * MiB;
constexpr size_t WS_WDN = 79 * MiB;
constexpr size_t WS_R3 = 101 * MiB;
constexpr size_t WS_R2 = 169 * MiB;
constexpr size_t WS_R1 = 305 * MiB;
constexpr size_t WS_END = 509 * MiB;
constexpr size_t R2_CS_OFF = 68 * MiB;
constexpr size_t R3_HTC_OFF = 64 * MiB;

constexpr int LDS_BYTES = 147456;

typedef unsigned short bf16_t;
typedef short bf16x8 __attribute__((ext_vector_type(8)));
typedef short s16x4 __attribute__((ext_vector_type(4)));
typedef float f32x4 __attribute__((ext_vector_type(4)));
typedef float f32x2 __attribute__((ext_vector_type(2)));
typedef float f32x16 __attribute__((ext_vector_type(16)));
typedef unsigned u32x4 __attribute__((ext_vector_type(4)));
typedef unsigned u32x2 __attribute__((ext_vector_type(2)));
#define LAS __attribute__((address_space(3)))

__device__ __forceinline__ unsigned cvt_pk_bf16(float lo, float hi) { unsigned r; asm volatile("v_cvt_pk_bf16_f32 %0, %1, %2" : "=v"(r) : "v"(lo), "v"(hi)); return r; }
__device__ __forceinline__ unsigned f2bf(float f) { unsigned u = __builtin_bit_cast(unsigned, f); return (u + 0x7fffu + ((u >> 16) & 1u)) >> 16; }
__device__ __forceinline__ float bflo(unsigned u) { return __builtin_bit_cast(float, u << 16); }
__device__ __forceinline__ float bfhi(unsigned u) { return __builtin_bit_cast(float, u & 0xffff0000u); }
__device__ __forceinline__ int tid_l() { int t = threadIdx.x; asm volatile("" : "+v"(t)); return t; }
__device__ __forceinline__ float wave_sum(float v) {
#pragma unroll
    for (int o = 1; o < 64; o <<= 1) v += __shfl_xor(v, o);
    return v;
}
__device__ __forceinline__ float sum16(float v) { v += __shfl_xor(v, 1); v += __shfl_xor(v, 2); v += __shfl_xor(v, 4); v += __shfl_xor(v, 8); return v; }
__device__ __forceinline__ float silu_f(float g) { return g * __builtin_amdgcn_rcpf(1.0f + __builtin_amdgcn_exp2f(-1.4426950408889634f * g)); }

#ifndef SPLITK_CTX
#define SPLITK_CTX 1
#endif
namespace pg8 {
constexpr int BM = 256, BK = 64, HALF = 128, HTB = HALF * BK * 2, STAGE_BYTES = 8 * HTB, NXCD = 8, WGM = 4;
__device__ __forceinline__ int lds_byte(int r, int c) { const int st = (r >> 4) * 2 + (c >> 5), rr = r & 15, cc = c & 31, ob = rr * 64 + cc * 2; return st * 1024 + (ob ^ (((ob >> 9) & 1) << 5)); }
__device__ __forceinline__ void stage_rc(int b, int& R, int& C) { const int st = b / 1024, sb = b % 1024, swz = sb ^ (((sb >> 9) & 1) << 5); R = (st >> 1) * 16 + swz / 64; C = (st & 1) * 32 + (swz % 64) / 2; }
__device__ __forceinline__ int perm32(int rho) { const int n = rho >> 4, i = rho & 15; return 8 * (i >> 2) + 4 * n + (i & 3); }

struct Unit { int pm, pn, z; };
struct Gemm { const bf16_t* A; const bf16_t* Bt; int lda, ldb, K; size_t aZ, bZ; };

struct Order {
    int nM, nN, nZ, nwg, G, c, mode;
    __device__ void init(int nM_, int nN_, int nZ_, int G_, int c_, int mode_ = 0) { nM = nM_; nN = nN_; nZ = nZ_; nwg = nM * nN * nZ; G = G_; c = c_; mode = mode_; }
    __device__ bool next(int i, Unit& u) const {
        const long L = (long)i * G + c; if (L >= nwg) return false;
        int wgid = (int)L; { const int q = nwg / NXCD, r = nwg % NXCD, xcd = wgid % NXCD, off = wgid / NXCD; wgid = (xcd < r ? xcd * (q + 1) : r * (q + 1) + (xcd - r) * q) + off; }
        const int per = nM * nN; u.z = wgid / per; wgid -= u.z * per;
        const int nig = WGM * nN, gid = wgid / nig, fm = gid * WGM, gsz = (nM - fm) < WGM ? (nM - fm) : WGM;
        const int pm = fm + ((wgid % nig) % gsz); u.pn = (wgid % nig) / gsz;
        u.pm = (mode == 1) ? pm * NTILE_B : (mode == 2) ? pm + (pm >> 4) + 1 : pm; return true;
    }
};

struct EpiStore {
    bf16_t* O; int ldc; size_t oZ; const float* rope; int rope_tiles;
    __device__ __forceinline__ void operator()(f32x4 (&acc)[2][2][4][2], const Unit& u, int wr, int wc, int fr, int fq) const {
        bf16_t* base = O + (size_t)u.z * oZ + (size_t)(u.pm * BM + wr * 64 + fr) * ldc + u.pn * BM + wc * 32 + 8 * fq;
        const int tt = u.pm % NTILE_B; const bool do_rope = rope && u.pn < rope_tiles && tt != 0;
        const float qs = (rope && u.pn < 4) ? 0.125f * 1.4426950408889634f : 1.0f;
#pragma unroll
        for (int ai = 0; ai < 2; ++ai)
#pragma unroll
            for (int m = 0; m < 4; ++m) { bf16_t* rowp = base + (size_t)(ai * HALF + m * 16) * ldc;
                f32x4 cs0 = (f32x4){1.f, 0.f, 1.f, 0.f}, cs1 = cs0;
                if (do_rope) { const int tl = (tt - 1) * 256 + ai * HALF + wr * 64 + m * 16 + fr, pos = (wc & 1) ? (tl & 63) : (tl >> 6);
                    const float* tp = rope + (pos * 16 + 4 * fq) * 2; cs0 = *(const f32x4*)tp; cs1 = *(const f32x4*)(tp + 4); }
#pragma unroll
                for (int bj = 0; bj < 2; ++bj) { const f32x4 v0 = acc[ai][bj][m][0] * qs, v1 = acc[ai][bj][m][1] * qs;
                    u32x4 w; w.x = cvt_pk_bf16(v0[0] * cs0.x - v0[1] * cs0.y, v0[0] * cs0.y + v0[1] * cs0.x); w.y = cvt_pk_bf16(v0[2] * cs0.z - v0[3] * cs0.w, v0[2] * cs0.w + v0[3] * cs0.z);
                    w.z = cvt_pk_bf16(v1[0] * cs1.x - v1[1] * cs1.y, v1[0] * cs1.y + v1[1] * cs1.x); w.w = cvt_pk_bf16(v1[2] * cs1.z - v1[3] * cs1.w, v1[2] * cs1.w + v1[3] * cs1.z);
                    *(u32x4*)(rowp + bj * HALF) = w; } }
    }
};
struct EpiPosDft {
    static constexpr bool PREFETCH = false;
    bf16_t* T; int row_off; int N;
    __device__ __forceinline__ void operator()(f32x4 (&acc)[2][2][4][2], const Unit& u, int wr, int wc, int fr, int fq) const {
        const size_t rowb = (size_t)u.z * RPB + row_off; const int colb = u.pn * 512 + wc * 32 + 8 * fq;
#pragma unroll
        for (int ai = 0; ai < 2; ++ai)
#pragma unroll
            for (int m = 0; m < 4; ++m) { const int k = u.pm * HALF + wr * 64 + m * 16 + fr;
#pragma unroll
                for (int bj = 0; bj < 2; ++bj) { const f32x4 v0 = acc[ai][bj][m][0], v1 = acc[ai][bj][m][1];
                    u32x4 w; w.x = cvt_pk_bf16(v0[0], v0[1]); w.y = cvt_pk_bf16(v0[2], v0[3]); w.z = cvt_pk_bf16(v1[0], v1[1]); w.w = cvt_pk_bf16(v1[2], v1[3]);
                    const int col = colb + bj * HALF;
                    if (ai == 1 && k == 0) { const u32x4 zz = {0u, 0u, 0u, 0u};
                        *(u32x4*)(T + (rowb + N / 2) * 2048 + col) = w; *(u32x4*)(T + (rowb + N / 2) * 2048 + col + 256) = zz; *(u32x4*)(T + rowb * 2048 + col + 256) = zz; }
                    else { *(u32x4*)(T + (rowb + k) * 2048 + col + ai * 256) = w;
                        if (k != 0) { u32x4 wm = w; if (ai) { wm.x ^= 0x80008000u; wm.y ^= 0x80008000u; wm.z ^= 0x80008000u; wm.w ^= 0x80008000u; }
                            *(u32x4*)(T + (rowb + N - k) * 2048 + col + ai * 256) = wm; } } } }
    }
};
struct EpiSwiGLU {
    bf16_t* O;
    __device__ __forceinline__ void operator()(f32x4 (&acc)[2][2][4][2], const Unit& u, int wr, int wc, int fr, int fq) const {
        bf16_t* base = O + (size_t)(u.pm * BM + wr * 64 + fr) * DFF + u.pn * HALF + wc * 32 + 8 * fq;
#pragma unroll
        for (int ai = 0; ai < 2; ++ai)
#pragma unroll
            for (int m = 0; m < 4; ++m) { bf16_t* rowp = base + (size_t)(ai * HALF + m * 16) * DFF;
                const f32x4 g0 = acc[ai][0][m][0], g1 = acc[ai][0][m][1], u0 = acc[ai][1][m][0], u1 = acc[ai][1][m][1];
                u32x4 w; w.x = cvt_pk_bf16(silu_f(g0[0]) * u0[0], silu_f(g0[1]) * u0[1]); w.y = cvt_pk_bf16(silu_f(g0[2]) * u0[2], silu_f(g0[3]) * u0[3]);
                w.z = cvt_pk_bf16(silu_f(g1[0]) * u1[0], silu_f(g1[1]) * u1[1]); w.w = cvt_pk_bf16(silu_f(g1[2]) * u1[2], silu_f(g1[3]) * u1[3]);
                *(u32x4*)rowp = w; }
    }
};
struct EpiResid {
    const float* xin_l; const float* xin_c; float* xout_l; float* xout_c; const float* gate; const float* bias; float* part;
    int hmode; bf16_t* H; const float* nln; const float* nmod; float* xbuf; unsigned* cnt; LAS unsigned char* xl;
    __device__ __forceinline__ void operator()(f32x4 (&acc)[2][2][4][2], const Unit& u, int wr, int wc, int fr, int fq) const {
        const int b = u.pm / NTILE_B, tt = u.pm - b * NTILE_B; const bool isc = (tt == 0);
        const int col0 = u.pn * BM + wc * 32 + 8 * fq;
        if (part) {
            float* P = part + ((size_t)u.z * (NB * CTXL) + (size_t)b * CTXL + wr * 64 + fr) * DM + col0;
#pragma unroll
            for (int ai = 0; ai < 2; ++ai)
#pragma unroll
                for (int m = 0; m < 4; ++m) { const size_t ro = (size_t)(ai * HALF + m * 16) * DM;
#pragma unroll
                    for (int bj = 0; bj < 2; ++bj)
#pragma unroll
                        for (int n = 0; n < 2; ++n) *(f32x4*)(P + ro + bj * HALF + 4 * n) = acc[ai][bj][m][n]; }
            return;
        }
        const size_t rowbase = isc ? (size_t)b * CTXL : (size_t)b * SEQ + (size_t)(tt - 1) * 256;
        const float* xin = (isc ? xin_c : xin_l) + (rowbase + wr * 64 + fr) * DM; float* xout = (isc ? xout_c : xout_l) + (rowbase + wr * 64 + fr) * DM;
        const float* g = gate + (isc ? 8 : b) * 6144 + col0;
        if (bias) {
#pragma unroll
            for (int bj = 0; bj < 2; ++bj)
#pragma unroll
                for (int n = 0; n < 2; ++n) { const f32x4 bv = *(const f32x4*)(bias + col0 + bj * HALF + 4 * n);
#pragma unroll
                    for (int ai = 0; ai < 2; ++ai)
#pragma unroll
                        for (int m = 0; m < 4; ++m) acc[ai][bj][m][n] += bv; }
        }
        f32x4 gv[2][2];
#pragma unroll
        for (int bj = 0; bj < 2; ++bj)
#pragma unroll
            for (int n = 0; n < 2; ++n) gv[bj][n] = *(const f32x4*)(g + bj * HALF + 4 * n);
#pragma unroll
        for (int ai = 0; ai < 2; ++ai) {
            f32x4 xi[4][2][2];
#pragma unroll
            for (int m = 0; m < 4; ++m)
#pragma unroll
                for (int bj = 0; bj < 2; ++bj)
#pragma unroll
                    for (int n = 0; n < 2; ++n) xi[m][bj][n] = *(const f32x4*)(xin + (size_t)(ai * HALF + m * 16) * DM + col0 + bj * HALF + 4 * n);
            asm volatile("s_waitcnt vmcnt(0)" ::: "memory");
#pragma unroll
            for (int m = 0; m < 4; ++m)
#pragma unroll
                for (int bj = 0; bj < 2; ++bj)
#pragma unroll
                    for (int n = 0; n < 2; ++n) { acc[ai][bj][m][n] = xi[m][bj][n] + gv[bj][n] * acc[ai][bj][m][n];
                        if (hmode != 2) *(f32x4*)(xout + (size_t)(ai * HALF + m * 16) * DM + col0 + bj * HALF + 4 * n) = acc[ai][bj][m][n]; }
            asm volatile("" ::: "memory");
        }
        if (hmode == 0) return;
        LAS float* P = (LAS float*)xl; LAS float* S = (LAS float*)(xl + 4096);
        const int tid = tid_l(), lane = tid & 63, wid = tid >> 6, pmi = b * 16 + (tt - 1);
#pragma unroll
        for (int ai = 0; ai < 2; ++ai)
#pragma unroll
            for (int m = 0; m < 4; ++m) { float s = 0.f;
#pragma unroll
                for (int bj = 0; bj < 2; ++bj)
#pragma unroll
                    for (int n = 0; n < 2; ++n) { const f32x4 a = acc[ai][bj][m][n]; s += (a[0] * a[0] + a[1] * a[1]) + (a[2] * a[2] + a[3] * a[3]); }
                s += __shfl_xor(s, 16); s += __shfl_xor(s, 32);
                if (fq == 0) P[(ai * HALF + wr * 64 + m * 16 + fr) * 4 + wc] = s; }
        asm volatile("s_waitcnt lgkmcnt(0)" ::: "memory"); __builtin_amdgcn_s_barrier(); asm volatile("" ::: "memory");
        const int prow = wid * 32 + (lane & 31);
        if (lane < 32) { const f32x4 q4 = *(const LAS f32x4*)(P + prow * 4);
            __hip_atomic_store(xbuf + ((size_t)pmi * 256 + prow) * 4 + u.pn, (q4[0] + q4[1]) + (q4[2] + q4[3]), __ATOMIC_RELAXED, __HIP_MEMORY_SCOPE_AGENT); }
        asm volatile("s_waitcnt vmcnt(0)" ::: "memory");
        if (lane == 0) __hip_atomic_fetch_add(cnt + 64 * pmi, 1u, __ATOMIC_RELAXED, __HIP_MEMORY_SCOPE_AGENT);
        if (wid == 0) { unsigned sp = 0;
            while ((unsigned)__builtin_amdgcn_readfirstlane(__hip_atomic_load(cnt + 64 * pmi, __ATOMIC_RELAXED, __HIP_MEMORY_SCOPE_AGENT)) < 32u) { __builtin_amdgcn_s_sleep(1); if (++sp > (1u << 22)) break; }
            }
        asm volatile("s_waitcnt vmcnt(0) lgkmcnt(0)" ::: "memory"); __builtin_amdgcn_s_barrier(); asm volatile("" ::: "memory");
        if (lane < 32) { const float* sl4 = xbuf + ((size_t)pmi * 256 + prow) * 4; float tsum = 0.f;
#pragma unroll
            for (int t = 0; t < 4; ++t) tsum += __hip_atomic_load(sl4 + t, __ATOMIC_RELAXED, __HIP_MEMORY_SCOPE_AGENT);
            S[prow] = __builtin_amdgcn_rsqf(tsum * (1.0f / DM) + EPS); }
        asm volatile("s_waitcnt vmcnt(0) lgkmcnt(0)" ::: "memory"); __builtin_amdgcn_s_barrier(); asm volatile("" ::: "memory");
        int c0 = col0, rl = wr * 64 + fr; asm volatile("" : "+v"(c0), "+v"(rl));
        f32x4 Am[2][2], Bm[2][2];
#pragma unroll
        for (int bj = 0; bj < 2; ++bj)
#pragma unroll
            for (int n = 0; n < 2; ++n) { const int c = c0 + bj * HALF + 4 * n; const f32x4 l4 = *(const f32x4*)(nln + c);
                if (hmode == 1) { Am[bj][n] = l4 * (*(const f32x4*)(nmod + b * 6144 + 1024 + c) + 1.0f); Bm[bj][n] = *(const f32x4*)(nmod + b * 6144 + c); }
                else { Am[bj][n] = l4; Bm[bj][n] = (f32x4){0.f, 0.f, 0.f, 0.f}; } }
        bf16_t* hbase = H + ((size_t)u.pm * BM + rl) * DM + c0; float* obase = (isc ? xout_c : xout_l) + (rowbase + rl) * DM + c0;
#pragma unroll
        for (int ai = 0; ai < 2; ++ai)
#pragma unroll
            for (int m = 0; m < 4; ++m) { const int r = ai * HALF + m * 16; const float rs = S[r + rl];
                if (hmode == 1) {
#pragma unroll
                    for (int bj = 0; bj < 2; ++bj) { const f32x4 y0 = acc[ai][bj][m][0] * rs * Am[bj][0] + Bm[bj][0], y1 = acc[ai][bj][m][1] * rs * Am[bj][1] + Bm[bj][1];
                        u32x4 w; w.x = cvt_pk_bf16(y0[0], y0[1]); w.y = cvt_pk_bf16(y0[2], y0[3]); w.z = cvt_pk_bf16(y1[0], y1[1]); w.w = cvt_pk_bf16(y1[2], y1[3]);
                        *(u32x4*)(hbase + (size_t)r * DM + bj * HALF) = w; } }
                else {
#pragma unroll
                    for (int bj = 0; bj < 2; ++bj)
#pragma unroll
                        for (int n = 0; n < 2; ++n) *(f32x4*)(obase + (size_t)r * DM + bj * HALF + 4 * n) = acc[ai][bj][m][n] * rs * Am[bj][n]; } }
    }
};

template <class Epi>
__device__ __forceinline__ void gemm_phase(LAS unsigned char* lds, const Gemm g, const Order& S, const Epi& E) {
    const int tid = tid_l(), wid = __builtin_amdgcn_readfirstlane(tid >> 6), lane = tid & 63, wr = wid >> 2, wc = wid & 3, fr = lane & 15, fq = lane >> 4;
    const int K = g.K, nt = K / BK;
    unsigned voffA[2], voffB[2];
#pragma unroll
    for (int i = 0; i < 2; ++i) { int R, C; stage_rc(tid * 16 + i * 8192, R, C); const int Rb = (R & ~31) + perm32(R & 31);
        voffA[i] = (unsigned)(R * g.lda + C) * 2u; voffB[i] = (unsigned)(Rb * g.ldb + C) * 2u; }
    const size_t kstep = (size_t)(BK * 2);
    const size_t hsA = (size_t)HALF * g.lda * 2, hsB = (size_t)HALF * g.ldb * 2;
    const size_t tsA = 2 * hsA, tsB = 2 * hsB;
    const unsigned ldsw = (unsigned)wid * 1024u;
    const int aoff = lds_byte(wr * 64 + fr, fq * 8), boff = lds_byte(wc * 32 + fr, fq * 8);
#define PG8_SA(b, h) (((b) * 2 + (h)) * HTB)
#define PG8_SB(b, h) ((4 + (b) * 2 + (h)) * HTB)
#define PG8_STAGE(bufoff, gbase, voff) do { _Pragma("unroll") for (int _i = 0; _i < 2; ++_i) \
        __builtin_amdgcn_global_load_lds((const unsigned*)((const char*)(gbase) + (voff)[_i]), (LAS unsigned*)(lds + (bufoff) + ldsw + _i * 8192), 16, 0, 0); } while (0)
#define PG8_LDA(dst, b, h) do { _Pragma("unroll") for (int m = 0; m < 4; ++m) _Pragma("unroll") for (int k = 0; k < 2; ++k) dst[m][k] = *(const LAS bf16x8*)(lds + PG8_SA(b, h) + aoff + m * 2048 + k * 1024); } while (0)
#define PG8_LDB(dst, b, h) do { _Pragma("unroll") for (int n = 0; n < 2; ++n) _Pragma("unroll") for (int k = 0; k < 2; ++k) dst[n][k] = *(const LAS bf16x8*)(lds + PG8_SB(b, h) + boff + n * 2048 + k * 1024); } while (0)
#define PG8_MMA(ai, bj, At, Bt) do { __builtin_amdgcn_s_setprio(1); _Pragma("unroll") for (int m = 0; m < 4; ++m) _Pragma("unroll") for (int n = 0; n < 2; ++n) _Pragma("unroll") for (int k = 0; k < 2; ++k) \
        acc[ai][bj][m][n] = __builtin_amdgcn_mfma_f32_16x16x32_bf16(Bt[n][k], At[m][k], acc[ai][bj][m][n], 0, 0, 0); __builtin_amdgcn_s_setprio(0); } while (0)
#define PG8_WAIT_V(n) asm volatile("s_waitcnt vmcnt(" #n ")" ::: "memory")
#define PG8_WAIT_L(n) asm volatile("s_waitcnt lgkmcnt(" #n ")" ::: "memory")
#define PG8_BAR __builtin_amdgcn_s_barrier()
#define PG8_SCHED __builtin_amdgcn_sched_barrier(0)
    Unit cur, nxt; int ui = 0;
    if (!S.next(0, cur)) return;
    f32x4 acc[2][2][4][2];
#pragma unroll
    for (int a = 0; a < 2; ++a)
#pragma unroll
        for (int b = 0; b < 2; ++b)
#pragma unroll
            for (int m = 0; m < 4; ++m)
#pragma unroll
                for (int n = 0; n < 2; ++n) acc[a][b][m][n] = (f32x4){0.f, 0.f, 0.f, 0.f};
    bf16x8 At[4][2], B0[2][2], B1[2][2];
    const char* cA = (const char*)g.A + (size_t)cur.z * g.aZ + (size_t)cur.pm * tsA; const char* cB = (const char*)g.Bt + (size_t)cur.z * g.bZ + (size_t)cur.pn * tsB;
    PG8_STAGE(PG8_SB(0, 0), cB, voffB); PG8_STAGE(PG8_SB(0, 1), cB + hsB, voffB); PG8_STAGE(PG8_SA(0, 0), cA, voffA); PG8_STAGE(PG8_SA(0, 1), cA + hsA, voffA);
    if (wr == 1) PG8_BAR;
    PG8_WAIT_V(2); PG8_BAR;
    PG8_STAGE(PG8_SB(1, 0), cB + kstep, voffB); PG8_STAGE(PG8_SA(1, 0), cA + kstep, voffA); PG8_STAGE(PG8_SB(1, 1), cB + hsB + kstep, voffB);
    PG8_WAIT_V(6); PG8_BAR;
    for (;;) {
        const bool has_next = S.next(ui + 1, nxt);
        const char* nA = has_next ? (const char*)g.A + (size_t)nxt.z * g.aZ + (size_t)nxt.pm * tsA : cA; const char* nB = has_next ? (const char*)g.Bt + (size_t)nxt.z * g.bZ + (size_t)nxt.pn * tsB : cB;
        for (int t = 0; t < nt; t += 2) {
            const bool last = (t == nt - 2);
            const char* a1 = cA + (size_t)(t + 1) * kstep;
            const char* a2 = last ? nA : cA + (size_t)(t + 2) * kstep; const char* b2 = last ? nB : cB + (size_t)(t + 2) * kstep;
            const char* a3 = a2 + kstep; const char* b3 = b2 + kstep;
            PG8_LDB(B0, 0, 0); PG8_LDB(B1, 0, 1); PG8_SCHED; PG8_LDA(At, 0, 0); PG8_STAGE(PG8_SA(1, 1), a1 + hsA, voffA);
            PG8_WAIT_V(8); PG8_WAIT_L(0); PG8_BAR; PG8_MMA(0, 0, At, B0); PG8_MMA(0, 1, At, B1); PG8_BAR; PG8_SCHED;
            PG8_LDA(At, 0, 1); PG8_STAGE(PG8_SB(0, 0), b2, voffB); PG8_STAGE(PG8_SB(0, 1), b2 + hsB, voffB); PG8_STAGE(PG8_SA(0, 0), a2, voffA);
            PG8_WAIT_V(8); PG8_WAIT_L(0); PG8_BAR; PG8_MMA(1, 0, At, B0); PG8_MMA(1, 1, At, B1); PG8_BAR; PG8_SCHED;
            PG8_LDB(B0, 1, 0); PG8_LDB(B1, 1, 1); PG8_SCHED; PG8_LDA(At, 1, 0); PG8_STAGE(PG8_SA(0, 1), a2 + hsA, voffA);
            PG8_WAIT_V(8); PG8_WAIT_L(0); PG8_BAR; PG8_MMA(0, 0, At, B0); PG8_MMA(0, 1, At, B1); PG8_BAR; PG8_SCHED;
            PG8_LDA(At, 1, 1); PG8_STAGE(PG8_SB(1, 0), b3, voffB); PG8_STAGE(PG8_SB(1, 1), b3 + hsB, voffB); PG8_STAGE(PG8_SA(1, 0), a3, voffA);
            PG8_WAIT_V(8); PG8_WAIT_L(0); PG8_BAR; PG8_MMA(1, 0, At, B0); PG8_MMA(1, 1, At, B1); PG8_BAR; PG8_SCHED;
        }
        if (wr == 0) PG8_BAR;
        E(acc, cur, wr, wc, fr, fq);
        if (!has_next) break;
#pragma unroll
        for (int a = 0; a < 2; ++a)
#pragma unroll
            for (int b = 0; b < 2; ++b)
#pragma unroll
                for (int m = 0; m < 4; ++m)
#pragma unroll
                    for (int n = 0; n < 2; ++n) acc[a][b][m][n] = (f32x4){0.f, 0.f, 0.f, 0.f};
        cur = nxt; cA = nA; cB = nB; ++ui;
        if (wr == 1) PG8_BAR;
    }
    PG8_WAIT_V(0);
    PG8_BAR;
#undef PG8_SA
#undef PG8_SB
#undef PG8_STAGE
#undef PG8_LDA
#undef PG8_LDB
#undef PG8_MMA
#undef PG8_WAIT_V
#undef PG8_WAIT_L
#undef PG8_BAR
#undef PG8_SCHED
}
}

namespace att {
constexpr int NW = 8, QBLK = 32, KVBLK = 64;
constexpr size_t SHM_V = KVBLK * 128 * 2, SHM_K = KVBLK * 128 * 2, SHM_ATTN = 2 * SHM_V + 2 * SHM_K + NW * 64 * 4;
#define KSWZ(row, colB) ((row) * 256 + ((colB) ^ (((row) & 7) << 4)))
#define SBAR() __builtin_amdgcn_sched_barrier(0)
__device__ __forceinline__ int crow(int r, int hi) { return (r & 3) + 8 * (r >> 2) + 4 * hi; }
__device__ __forceinline__ unsigned cvtpk(float lo, float hi) { unsigned r; asm volatile("v_cvt_pk_bf16_f32 %0, %1, %2" : "=v"(r) : "v"(lo), "v"(hi)); return r; }

__device__ __forceinline__ void partialSM(f32x16& p0, f32x16& p1, float& m_reg, float& mn, float& alpha, const float C, const float thr_raw) {
  float pmax = p0[0];
#pragma unroll
  for (int r = 1; r < 16; ++r) pmax = fmaxf(pmax, p0[r]);
#pragma unroll
  for (int r = 0; r < 16; ++r) pmax = fmaxf(pmax, p1[r]);
  { auto rr = __builtin_amdgcn_permlane32_swap(__float_as_uint(pmax), __float_as_uint(pmax), false, false);
    pmax = fmaxf(__uint_as_float(rr[0]), __uint_as_float(rr[1])); }
  if (__builtin_expect(__all(pmax - m_reg <= thr_raw), 1)) { mn = m_reg; alpha = 1.f; }
  else { mn = fmaxf(m_reg, pmax); alpha = __builtin_amdgcn_exp2f((m_reg - mn) * C); m_reg = mn; }
  float mnC = -mn * C;
#pragma unroll
  for (int r = 0; r < 16; ++r) p0[r] = fmaf(p0[r], C, mnC);
#pragma unroll
  for (int r = 0; r < 16; ++r) p1[r] = fmaf(p1[r], C, mnC);
#pragma unroll
  for (int r = 0; r < 16; ++r) p0[r] = __builtin_amdgcn_exp2f(p0[r]);
}
__device__ __forceinline__ void partialSM_pre(f32x16& p0, f32x16& p1, float& m_ref, float& alpha, const float thr2) {
  if (__builtin_expect(__any(m_ref != 0.f), 0)) {
#pragma unroll
    for (int r = 0; r < 16; ++r) { p0[r] -= m_ref; p1[r] -= m_ref; } }
  float pmax = p0[0];
#pragma unroll
  for (int r = 1; r < 16; ++r) pmax = fmaxf(pmax, p0[r]);
#pragma unroll
  for (int r = 0; r < 16; ++r) pmax = fmaxf(pmax, p1[r]);
  { auto rr = __builtin_amdgcn_permlane32_swap(__float_as_uint(pmax), __float_as_uint(pmax), false, false);
    pmax = fmaxf(__uint_as_float(rr[0]), __uint_as_float(rr[1])); }
  if (__builtin_expect(__all(pmax <= thr2), 1)) { alpha = 1.f; }
  else { const float dl = fmaxf(pmax, 0.f); m_ref += dl; alpha = __builtin_amdgcn_exp2f(-dl);
#pragma unroll
    for (int r = 0; r < 16; ++r) { p0[r] -= dl; p1[r] -= dl; } }
#pragma unroll
  for (int r = 0; r < 16; ++r) p0[r] = __builtin_amdgcn_exp2f(p0[r]);
}
__device__ __forceinline__ void finishSM(f32x16& p0, f32x16& p1, float alpha, float& l_reg, bf16x8& pa0, bf16x8& pa1, bf16x8& pa2, bf16x8& pa3) {
#pragma unroll
  for (int r = 0; r < 16; ++r) p1[r] = __builtin_amdgcn_exp2f(p1[r]);
  float ps = 0;
#pragma unroll
  for (int r = 0; r < 16; ++r) ps += p0[r];
#pragma unroll
  for (int r = 0; r < 16; ++r) ps += p1[r];
  { auto rr = __builtin_amdgcn_permlane32_swap(__float_as_uint(ps), __float_as_uint(ps), false, false);
    ps = __uint_as_float(rr[0]) + __uint_as_float(rr[1]); }
  l_reg = l_reg * alpha + ps;
#define PK4(P, BASE, OUT) do { unsigned a0 = cvtpk(P[BASE + 0], P[BASE + 1]), a1 = cvtpk(P[BASE + 2], P[BASE + 3]);   \
    unsigned b0 = cvtpk(P[BASE + 4], P[BASE + 5]), b1 = cvtpk(P[BASE + 6], P[BASE + 7]);                              \
    auto r0 = __builtin_amdgcn_permlane32_swap(a0, b0, false, false); auto r1 = __builtin_amdgcn_permlane32_swap(a1, b1, false, false); \
    u32x4 w = {r0[0], r1[0], r0[1], r1[1]}; OUT = *reinterpret_cast<bf16x8*>(&w); } while (0)
  PK4(p0, 0, pa0); PK4(p0, 8, pa1); PK4(p1, 0, pa2); PK4(p1, 8, pa3);
#undef PK4
}
template <int ND0>
__device__ __forceinline__ void qkt(f32x16& p0, f32x16& p1, const char* Ks, const bf16x8* qr, int r32, int hi) {
  p0 = f32x16{}; p1 = f32x16{};
#pragma unroll
  for (int d0 = 0; d0 < ND0; ++d0) { int cb = (d0 * 16 + hi * 8) * 2;
    bf16x8 b0 = *reinterpret_cast<const bf16x8*>(Ks + KSWZ(r32, cb));
    bf16x8 b1 = *reinterpret_cast<const bf16x8*>(Ks + KSWZ(32 + r32, cb));
    p0 = __builtin_amdgcn_mfma_f32_32x32x16_bf16(b0, qr[d0], p0, 0, 0, 0);
    p1 = __builtin_amdgcn_mfma_f32_32x32x16_bf16(b1, qr[d0], p1, 0, 0, 0); }
}
__device__ __forceinline__ int v_st(int k, int c) { const int kk = (k & ~0xC) | ((k & 4) << 1) | ((k & 8) >> 1); return ((kk >> 3) * 4 + (c >> 5)) * 512 + ((kk & 7) * 32 + (c & 31)) * 2; }
__device__ __forceinline__ int v_rd_base(int lane) { return ((lane & 3) << 3) | (((lane >> 2) & 3) << 6) | (((lane >> 4) & 1) << 5) | (((lane >> 5) & 1) << 8); }
constexpr int v_rd_off(int d0, int ks, int half) { return d0 * 512 + ks * 4096 + half * 2048; }
template <int OFF> __device__ __forceinline__ s16x4 tr_read(int vb) {
  s16x4 r; asm volatile("ds_read_b64_tr_b16 %0, %1 offset:%2" : "=&v"(r) : "v"(vb), "i"(OFF) : "memory"); return r;
}
template <int D0> __device__ __forceinline__ void pv_one(f32x16& od, int vb, bf16x8 pa0, bf16x8 pa1, bf16x8 pa2, bf16x8 pa3) {
  const s16x4 l0 = tr_read<v_rd_off(D0, 0, 0)>(vb), h0 = tr_read<v_rd_off(D0, 0, 1)>(vb), l1 = tr_read<v_rd_off(D0, 1, 0)>(vb), h1 = tr_read<v_rd_off(D0, 1, 1)>(vb);
  const s16x4 l2 = tr_read<v_rd_off(D0, 2, 0)>(vb), h2 = tr_read<v_rd_off(D0, 2, 1)>(vb), l3 = tr_read<v_rd_off(D0, 3, 0)>(vb), h3 = tr_read<v_rd_off(D0, 3, 1)>(vb);
  asm volatile("s_waitcnt lgkmcnt(0)" ::: "memory"); SBAR();
#define PK(L, H) (bf16x8){L[0], L[1], L[2], L[3], H[0], H[1], H[2], H[3]}
  od = __builtin_amdgcn_mfma_f32_32x32x16_bf16(pa0, PK(l0, h0), od, 0, 0, 0);
  od = __builtin_amdgcn_mfma_f32_32x32x16_bf16(pa1, PK(l1, h1), od, 0, 0, 0);
  od = __builtin_amdgcn_mfma_f32_32x32x16_bf16(pa2, PK(l2, h2), od, 0, 0, 0);
  od = __builtin_amdgcn_mfma_f32_32x32x16_bf16(pa3, PK(l3, h3), od, 0, 0, 0);
#undef PK
}
__device__ __forceinline__ void pv_d0(f32x16* o, int vb, bf16x8 pa0, bf16x8 pa1, bf16x8 pa2, bf16x8 pa3) {
  pv_one<0>(o[0], vb, pa0, pa1, pa2, pa3); pv_one<1>(o[1], vb, pa0, pa1, pa2, pa3); pv_one<2>(o[2], vb, pa0, pa1, pa2, pa3); pv_one<3>(o[3], vb, pa0, pa1, pa2, pa3);
}

struct Pf { bf16x8 v0, v1, k0; };
template <int ND0, int LDQ, int LDK, int LDO>
__device__ __forceinline__ void attn_unit(const bf16_t* __restrict__ Qb, const bf16_t* __restrict__ Kh, const bf16_t* __restrict__ Vh, bf16_t* __restrict__ Ob,
                                          int seq, int kofs, float C, float thr_raw, char* lds, int mode, const float* sg, float lam, float gscale,
                                          bf16x8& pfv0, bf16x8& pfv1, bf16x8& pfk0, int have_pf, const bf16_t* qkv, int nbh, int nkofs) {
  const int tid = tid_l(), wid = tid >> 6, lane = tid & 63, r32 = lane & 31, hi = lane >> 5;
  char* V_lds = lds; char* K_lds = lds + 2 * SHM_V;
  float* ws = (float*)(lds + 2 * SHM_V + 2 * SHM_K) + wid * 64; float* li_l = ws; float* al_l = ws + 32;
  constexpr bool PRE = true;
  float m_reg = PRE ? 0.f : -1e30f, l_reg = 0; f32x16 o[4] = {}; bf16x8 qr[ND0];
  const bf16_t* Qw = Qb + (long)(wid * QBLK + r32) * LDQ + hi * 8;
#pragma unroll
  for (int d0 = 0; d0 < ND0; ++d0) qr[d0] = *reinterpret_cast<const bf16x8*>(Qw + d0 * 16);
  const int sr = tid >> 4, sc = (tid & 15) * 8, vst0 = v_st(sr, sc), vst1 = v_st(32 + sr, sc);
  const int vb0 = (int)(uintptr_t)V_lds + v_rd_base(lane);
  bf16x8 vs0a, vs1a, ks0a, ks1a = {}, vs0b, vs1b, ks0b, ks1b = {};
  const int kr = tid >> 3, kcb = kofs + (tid & 7) * 16;
#define KLOAD(dst0, dst1, k0) do { if constexpr (ND0 == 4) { dst0 = *reinterpret_cast<const bf16x8*>(&Kh[(long)((k0) + kr) * LDK + (kcb >> 1)]); } \
    else { dst0 = *reinterpret_cast<const bf16x8*>(&Kh[(long)((k0) + sr) * LDK + sc]); dst1 = *reinterpret_cast<const bf16x8*>(&Kh[(long)((k0) + 32 + sr) * LDK + sc]); } } while (0)
#define KWRITE(b, src0, src1) do { if constexpr (ND0 == 4) { *(bf16x8*)(K_lds + (b) * SHM_K + KSWZ(kr, kcb)) = src0; } \
    else { int kc = sc * 2; *(bf16x8*)(K_lds + (b) * SHM_K + KSWZ(sr, kc)) = src0; *(bf16x8*)(K_lds + (b) * SHM_K + KSWZ(32 + sr, kc)) = src1; } } while (0)
#define SLOAD_A(k0) do { vs0a = *reinterpret_cast<const bf16x8*>(&Vh[(long)((k0) + sr) * LDK + sc]); vs1a = *reinterpret_cast<const bf16x8*>(&Vh[(long)((k0) + 32 + sr) * LDK + sc]); KLOAD(ks0a, ks1a, k0); } while (0)
#define SLOAD_B(k0) do { vs0b = *reinterpret_cast<const bf16x8*>(&Vh[(long)((k0) + sr) * LDK + sc]); vs1b = *reinterpret_cast<const bf16x8*>(&Vh[(long)((k0) + 32 + sr) * LDK + sc]); KLOAD(ks0b, ks1b, k0); } while (0)
#define SWRITE_A(b) do { *(bf16x8*)(V_lds + (b) * SHM_V + vst0) = vs0a; *(bf16x8*)(V_lds + (b) * SHM_V + vst1) = vs1a; KWRITE(b, ks0a, ks1a); } while (0)
#define SWRITE_B(b) do { *(bf16x8*)(V_lds + (b) * SHM_V + vst0) = vs0b; *(bf16x8*)(V_lds + (b) * SHM_V + vst1) = vs1b; KWRITE(b, ks0b, ks1b); } while (0)
#define VWRITE_A(b) do { *(bf16x8*)(V_lds + (b) * SHM_V + vst0) = vs0a; *(bf16x8*)(V_lds + (b) * SHM_V + vst1) = vs1a; } while (0)
#define VWRITE_B(b) do { *(bf16x8*)(V_lds + (b) * SHM_V + vst0) = vs0b; *(bf16x8*)(V_lds + (b) * SHM_V + vst1) = vs1b; } while (0)
#define SWAIT() do { if constexpr (ND0 == 4) asm volatile("s_waitcnt vmcnt(3)" ::: "memory"); else asm volatile("s_waitcnt vmcnt(4)" ::: "memory"); } while (0)
#define PSM(P0, P1, MN, AL) do { if constexpr (PRE) partialSM_pre(P0, P1, m_reg, AL, 11.541560327111707f); else partialSM(P0, P1, m_reg, MN, AL, C, thr_raw); } while (0)
#define RESC(a) do { if (__any((a) < 1.f)) { if (hi == 0) al_l[r32] = (a); asm volatile("s_waitcnt lgkmcnt(0)" ::: "memory"); \
    _Pragma("unroll") for (int d = 0; d < 4; ++d) _Pragma("unroll") for (int r = 0; r < 16; ++r) o[d][r] *= al_l[crow(r, hi)]; } } while (0)
  f32x16 pA0, pA1, pB0, pB1; float mnA, mnB, alA, alB; bf16x8 pa0, pa1, pa2, pa3; const int NT = seq / KVBLK;
  const char* Kq0 = K_lds + kofs; const char* Kq1 = K_lds + SHM_K + kofs;
  if (ND0 == 4 && have_pf) { vs0a = pfv0; vs1a = pfv1; ks0a = pfk0; } else { SLOAD_A(0); }
  asm volatile("s_waitcnt vmcnt(0)" ::: "memory"); SWRITE_A(0); __syncthreads();
  qkt<ND0>(pA0, pA1, Kq0, qr, r32, hi); PSM(pA0, pA1, mnA, alA);
  SLOAD_B(KVBLK); if (2 < NT) SLOAD_A(2 * KVBLK);
  SWAIT(); SWRITE_B(1); __syncthreads();
  for (int j = 1; j + 1 < NT; j += 2) {
    SBAR(); qkt<ND0>(pB0, pB1, Kq1, qr, r32, hi);
    finishSM(pA0, pA1, alA, l_reg, pa0, pa1, pa2, pa3); SBAR();
    SLOAD_B((j + 2) * KVBLK); SBAR();
    pv_d0(o, vb0, pa0, pa1, pa2, pa3); KWRITE(0, ks0a, ks1a); PSM(pB0, pB1, mnB, alB);
    __syncthreads(); SWAIT(); VWRITE_A(0);
    RESC(alB); __syncthreads();
    SBAR(); qkt<ND0>(pA0, pA1, Kq0, qr, r32, hi);
    finishSM(pB0, pB1, alB, l_reg, pa0, pa1, pa2, pa3); SBAR();
    if (j + 3 < NT) SLOAD_A((j + 3) * KVBLK); SBAR();
    pv_d0(o, vb0 + (int)SHM_V, pa0, pa1, pa2, pa3); KWRITE(1, ks0b, ks1b); PSM(pA0, pA1, mnA, alA);
    __syncthreads(); SWAIT(); VWRITE_B(1);
    RESC(alA); __syncthreads();
  }
  SBAR(); qkt<ND0>(pB0, pB1, Kq1, qr, r32, hi);
  finishSM(pA0, pA1, alA, l_reg, pa0, pa1, pa2, pa3); SBAR();
  pv_d0(o, vb0, pa0, pa1, pa2, pa3); PSM(pB0, pB1, mnB, alB);
  __syncthreads(); RESC(alB);
  finishSM(pB0, pB1, alB, l_reg, pa0, pa1, pa2, pa3); SBAR();
  pv_d0(o, vb0 + (int)SHM_V, pa0, pa1, pa2, pa3);
  if constexpr (ND0 == 4) { if (nbh >= 0) {
      const bf16_t* nK = qkv + (size_t)(nbh >> 3) * RPB * LDK + 1024 + (nbh & 7) * 128; const bf16_t* nV = nK + 1024;
      pfv0 = *reinterpret_cast<const bf16x8*>(&nV[(long)sr * LDK + sc]); pfv1 = *reinterpret_cast<const bf16x8*>(&nV[(long)(32 + sr) * LDK + sc]);
      pfk0 = *reinterpret_cast<const bf16x8*>(&nK[(long)kr * LDK + ((nkofs + (tid & 7) * 16) >> 1)]); }
    else { pfv0 = bf16x8{}; pfv1 = bf16x8{}; pfk0 = bf16x8{}; } }
  if (hi == 0) li_l[r32] = l_reg; asm volatile("s_waitcnt lgkmcnt(0)" ::: "memory");
  float rli[16];
#pragma unroll
  for (int r = 0; r < 16; ++r) rli[r] = __builtin_amdgcn_rcpf(li_l[crow(r, hi)]);
  __syncthreads();
  bf16_t* stg = (bf16_t*)(lds + (mode == 1 ? 69632 : 0) + wid * 8192);
#pragma unroll
  for (int r = 0; r < 16; ++r) { const int orow = crow(r, hi);
#pragma unroll
    for (int d0 = 0; d0 < 4; ++d0) stg[orow * 128 + d0 * 32 + r32] = (bf16_t)f2bf(o[d0][r] * rli[r]); }
  asm volatile("s_waitcnt lgkmcnt(0)" ::: "memory");
  bf16_t* Ow = Ob + (long)(wid * QBLK) * LDO;
  if (mode == 0) {
#pragma unroll
    for (int i = 0; i < 8; ++i) { const int row = i * 4 + (lane >> 4), ch = lane & 15; const u32x4 v = *(const u32x4*)(stg + row * 128 + ch * 8); *(u32x4*)(Ow + (long)row * LDO + ch * 8) = v; }
  } else if (mode == 2) {
    const bf16_t* st1 = (const bf16_t*)(lds + 69632 + wid * 8192); const int ch = lane & 15;
    const f32x4 g0 = *(const f32x4*)(sg + ch * 8) * gscale, g1 = *(const f32x4*)(sg + ch * 8 + 4) * gscale;
#pragma unroll
    for (int i = 0; i < 8; ++i) { const int row = i * 4 + (lane >> 4); const u32x4 w2 = *(const u32x4*)(stg + row * 128 + ch * 8), w1 = *(const u32x4*)(st1 + row * 128 + ch * 8);
      float d[8] = {bflo(w1.x) - lam * bflo(w2.x), bfhi(w1.x) - lam * bfhi(w2.x), bflo(w1.y) - lam * bflo(w2.y), bfhi(w1.y) - lam * bfhi(w2.y),
                    bflo(w1.z) - lam * bflo(w2.z), bfhi(w1.z) - lam * bfhi(w2.z), bflo(w1.w) - lam * bflo(w2.w), bfhi(w1.w) - lam * bfhi(w2.w)};
      float ss = 0.f;
#pragma unroll
      for (int e = 0; e < 8; ++e) ss += d[e] * d[e];
      const float rstd = __builtin_amdgcn_rsqf(sum16(ss) * (1.0f / 128.0f) + EPS);
      u32x4 ov; ov.x = cvtpk(d[0] * rstd * g0.x, d[1] * rstd * g0.y); ov.y = cvtpk(d[2] * rstd * g0.z, d[3] * rstd * g0.w);
      ov.z = cvtpk(d[4] * rstd * g1.x, d[5] * rstd * g1.y); ov.w = cvtpk(d[6] * rstd * g1.z, d[7] * rstd * g1.w);
      *(u32x4*)(Ow + (long)row * LDO + ch * 8) = ov; }
  }
  __syncthreads();
#undef SLOAD_A
#undef VWRITE_A
#undef VWRITE_B
#undef PSM
#undef KLOAD
#undef KWRITE
#undef SLOAD_B
#undef SWRITE_A
#undef SWRITE_B
#undef SWAIT
#undef RESC
}
#undef SBAR
}


#define XB_TMO      128
#define XB_XCNT(j)  (256  + 64 * (j))
#define XB_XSUB(j)  (1280 + 64 * (j))
#define XB_XGEN(j)  (2304 + 64 * (j))
#define XB_TOP      3328
#define XB_TOPGEN   3392
#define XCD_BAR_WORDS 3456
#define XB_SPIN_CAP (1u << 18)
__device__ __forceinline__ unsigned xb_ld(unsigned* p)              { return __hip_atomic_load(p, __ATOMIC_RELAXED, __HIP_MEMORY_SCOPE_AGENT); }
__device__ __forceinline__ unsigned xb_add(unsigned* p, unsigned v) { return __hip_atomic_fetch_add(p, v, __ATOMIC_RELAXED, __HIP_MEMORY_SCOPE_AGENT); }
__device__ __forceinline__ unsigned xb_xcc_id() { return (unsigned)__builtin_amdgcn_s_getreg((3 << 11) | 20) & 0xFu; }
#define XB_SPIN(cond, bar) do { unsigned _sp = 0; while (cond) { __builtin_amdgcn_s_sleep(1); \
    if ((++_sp & 255u) == 0u) { if (xb_ld(&(bar)[XB_TMO])) break; if (_sp > XB_SPIN_CAP) { atomicAdd(&(bar)[XB_TMO], 1u); break; } } } } while (0)
__device__ __forceinline__ void xcd_barrier_complete(unsigned* bar, unsigned x, unsigned& nloc, unsigned& nx) {
    const unsigned G = gridDim.x * gridDim.y * gridDim.z;
    unsigned sum, cnt, mine, sp = 0u;
    for (;;) {
        sum = 0u; cnt = 0u; mine = 0u;
#pragma unroll
        for (unsigned j = 0; j < 16; ++j) { const unsigned c = xb_ld(&bar[XB_XCNT(j)]); sum += c; cnt += (c > 0u) ? 1u : 0u; mine = (j == x) ? c : mine; }
        if (sum == G) break;
        __builtin_amdgcn_s_sleep(1);
        if ((++sp & 255u) == 0u) { if (xb_ld(&bar[XB_TMO])) break; if (sp > XB_SPIN_CAP) { atomicAdd(&bar[XB_TMO], 1u); break; } }
    }
    nloc = mine > 0u ? mine : 1u; nx = cnt > 0u ? cnt : 1u;
}
__device__ __forceinline__ void xcd_barrier(unsigned* bar, volatile LAS unsigned* st) {
    asm volatile("s_waitcnt vmcnt(0)" ::: "memory");
    __syncthreads();
    if (threadIdx.x == 0) {
        const unsigned x = xb_xcc_id();
        __builtin_amdgcn_s_waitcnt(0);
        unsigned nloc = st[0], nx = st[1];
        if (nloc == 0u) { xcd_barrier_complete(bar, x, nloc, nx); st[0] = nloc; st[1] = nx; }
        const unsigned old = xb_add(&bar[XB_XSUB(x)], 1u);
        const unsigned gen = old / nloc;
        if (old + 1u == (gen + 1u) * nloc) {
            __builtin_amdgcn_fence(__ATOMIC_RELEASE, "agent");
            asm volatile("s_waitcnt vmcnt(0)" ::: "memory");
            const unsigned og = xb_add(&bar[XB_TOP], 1u);
            const unsigned tg = og / nx;
            if (og + 1u == (tg + 1u) * nx) xb_add(&bar[XB_TOPGEN], 1u);
            else XB_SPIN(xb_ld(&bar[XB_TOPGEN]) == tg, bar);
            __builtin_amdgcn_fence(__ATOMIC_ACQUIRE, "agent");
            xb_add(&bar[XB_XGEN(x)], 1u);
            asm volatile("s_waitcnt vmcnt(0)" ::: "memory");
        } else {
            XB_SPIN(xb_ld(&bar[XB_XGEN(x)]) == gen, bar);
            __builtin_amdgcn_fence(__ATOMIC_ACQUIRE, "agent");
            asm volatile("s_waitcnt vmcnt(0)" ::: "memory");
        }
    }
    __syncthreads();
}

struct Args { const float* in[21]; float* out; unsigned char* ws; int ph_lo, ph_hi; };

enum Kind { K_PRO = 0, K_NM_MIX, K_G_QKV, K_QKPOST, K_ATTN, K_COMBINE, K_G_OUT, K_NM_FFN, K_G_GU, K_G_DOWN, K_NM_T, K_G_POS, K_G_CH, K_FINAL };
constexpr int N_PHASES = 31;
__device__ __forceinline__ void decode_phase(int ph, int& layer, int& kind) {
    if (ph == 0) { layer = 0; kind = K_PRO; return; }
    if (ph == N_PHASES - 1) { layer = 3; kind = K_FINAL; return; }
    int p = ph - 1;
    if (p < 7) { layer = 0; kind = (p < 2) ? K_NM_MIX + p : (p == 2) ? K_ATTN : K_G_OUT + (p - 3); return; } p -= 7;
    if (p < 8) { layer = 1; kind = (p < 4) ? K_NM_MIX + p : K_NM_MIX + p + 1; return; } p -= 8;
    if (p < 7) { layer = 2; kind = (p == 0) ? K_NM_T : (p == 1) ? K_G_POS : (p == 2) ? K_G_CH : K_G_OUT + (p - 3); return; } p -= 7;
    layer = 3; kind = (p < 2) ? K_NM_MIX + p : (p == 2) ? K_ATTN : K_G_OUT + (p - 3);
}

__device__ __forceinline__ void transpose_item(const float* W, int K, int N, bf16_t* WT, int k0, int n0, int drow0, LAS float* scr, int lane) {
    float tv[32];
#pragma unroll
    for (int i = 0; i < 32; ++i) tv[i] = W[(size_t)(k0 + 2 * i + (lane >> 5)) * N + n0 + (lane & 31)];
#pragma unroll
    for (int i = 0; i < 32; ++i) scr[(2 * i + (lane >> 5)) * 33 + (lane & 31)] = tv[i];
    asm volatile("s_waitcnt lgkmcnt(0)" ::: "memory");
    const int c = lane & 7;
#pragma unroll
    for (int j = 0; j < 4; ++j) { const int n = (lane >> 3) + 8 * j; const LAS float* s = scr + (8 * c) * 33 + n;
        u32x4 o; o.x = cvt_pk_bf16(s[0 * 33], s[1 * 33]); o.y = cvt_pk_bf16(s[2 * 33], s[3 * 33]); o.z = cvt_pk_bf16(s[4 * 33], s[5 * 33]); o.w = cvt_pk_bf16(s[6 * 33], s[7 * 33]);
        *(u32x4*)(WT + (size_t)(drow0 + n) * K + k0 + 8 * c) = o; }
    asm volatile("s_waitcnt lgkmcnt(0)" ::: "memory");
}
__device__ __forceinline__ void transpose_matrix(const float* W, int K, int N, bf16_t* WT, bool perm_gu, int& itbase, int gw, int NGW, LAS float* scr, int lane) {
    const int nblk = N / 32, nitems = (K / 64) * nblk;
    int first = (gw - itbase % NGW + NGW) % NGW;
    for (int it = first; it < nitems; it += NGW) {
        const int kb = it / nblk, nb = it - kb * nblk, n0 = nb * 32; int drow0 = n0;
        if (perm_gu) { drow0 = (n0 < DFF) ? (n0 / 128) * 256 + (n0 % 128) : ((n0 - DFF) / 128) * 256 + 128 + ((n0 - DFF) % 128); }
        transpose_item(W, K, N, WT, kb * 64, n0, drow0, scr, lane);
    }
    itbase += nitems;
}

__global__ void __launch_bounds__(512, 2) fwd_megakernel(Args args) {
    extern __shared__ __attribute__((aligned(16))) unsigned char lds_raw[];
    LAS unsigned char* lds = (LAS unsigned char*)lds_raw;
    cg::grid_group grid = cg::this_grid();
    typedef __attribute__((address_space(4))) const Args* KArgsPtr;
    volatile LAS unsigned* bar_st = (volatile LAS unsigned*)(lds + LDS_BYTES - 64);
    unsigned* bar_words = (unsigned*)(args.ws + WS_BAR);
    if (threadIdx.x < 2) bar_st[threadIdx.x] = 0u;
    __syncthreads();
    if (threadIdx.x == 0) (void)xb_add(&bar_words[XB_XCNT(xb_xcc_id())], 1u);

    for (int sl_ = args.ph_lo; sl_ < args.ph_hi; ++sl_) {
#ifdef PROBE_MASK
        const int ph = sl_ >> 1; { int l_, k_; decode_phase(ph, l_, k_); if ((sl_ & 1) && !((PROBE_MASK >> k_) & 1)) continue; }
#else
        const int ph = sl_;
#endif
        int G = gridDim.x, bx = blockIdx.x; asm volatile("" : "+s"(G), "+s"(bx));
        const int NGW = G * 8, NGT = G * 512;
        const int tid = tid_l(), lane = tid & 63, wave = __builtin_amdgcn_readfirstlane(tid >> 6);
        const int gw = bx * 8 + wave, gtid = bx * 512 + tid;
        KArgsPtr ka = (KArgsPtr)__builtin_amdgcn_kernarg_segment_ptr(); asm volatile("" : "+s"(ka));
#define AIN(i) (ka->in[i])
        unsigned char* ws = ka->ws;
        const float* x_in = AIN(0); const float* c_in = AIN(1); const float* ctx_in = AIN(2); const float* cctx_in = AIN(3);
        float* modv = (float*)(ws + WS_MODV); float* ropeA = (float*)(ws + WS_ROPEA); float* ropeB = (float*)(ws + WS_ROPEB);
        float* xc_ws = (float*)(ws + WS_XC); float* xl_ws = ka->out;
        bf16_t* R1 = (bf16_t*)(ws + WS_R1); bf16_t* R2 = (bf16_t*)(ws + WS_R2); bf16_t* R3 = (bf16_t*)(ws + WS_R3);
        int layer, kind; decode_phase(ph, layer, kind);

        const int mixer = layer % 3, mj = layer / 3;
        const float* xl_cur = (layer == 0 && kind <= K_G_OUT) ? x_in : xl_ws;
        const float* xc_cur = xc_ws;
        const bool last = (layer == 3);
        const bool fuse_ok = (G == 256);
        if (fuse_ok && (kind == K_FINAL || (kind == K_NM_FFN && last))) continue;
        const float* modl = modv + (size_t)layer * 9 * 6144;
        pg8::Gemm gd{}, gd2{}; pg8::Order gS{}, gS2{}; pg8::EpiStore eS{}; pg8::EpiResid eR{}; int gk = 0, gk2 = 0; float* part2 = nullptr;
        switch (kind) {
        case K_PRO: {
            LAS float* scr = (LAS float*)(lds + wave * 8704);
            int itbase = 0;
            for (int l = 0; l < 2; ++l) transpose_matrix(AIN(10) + (size_t)l * 1024 * 3072, 1024, 3072, (bf16_t*)(ws + WS_WQKVA) + (size_t)l * 3072 * 1024, false, itbase, gw, NGW, scr, lane);
            for (int l = 0; l < 2; ++l) transpose_matrix(AIN(13) + (size_t)l * 1024 * 1024, 1024, 1024, (bf16_t*)(ws + WS_WOA) + (size_t)l * 1024 * 1024, false, itbase, gw, NGW, scr, lane);
            transpose_matrix(AIN(14), 1024, 1536, (bf16_t*)(ws + WS_WQKVB), false, itbase, gw, NGW, scr, lane);
            transpose_matrix(AIN(17), 1024, 1024, (bf16_t*)(ws + WS_WOB), false, itbase, gw, NGW, scr, lane);
            transpose_matrix(AIN(18), 1024, 1024, (bf16_t*)(ws + WS_WOC), false, itbase, gw, NGW, scr, lane);
            for (int l = 0; l < 4; ++l) transpose_matrix(AIN(8) + (size_t)l * 1024 * 5632, 1024, 5632, (bf16_t*)(ws + WS_WGU) + (size_t)l * 5632 * 1024, true, itbase, gw, NGW, scr, lane);
            for (int l = 0; l < 4; ++l) transpose_matrix(AIN(9) + (size_t)l * 2816 * 1024, 2816, 1024, (bf16_t*)(ws + WS_WDN) + (size_t)l * 1024 * 2816, false, itbase, gw, NGW, scr, lane);
            LAS float* sl = (LAS float*)(lds + 69632);
            LAS float* part = (LAS float*)(lds + 69632 + 36864);
            for (int i = tid; i < 9 * 1024; i += 512) { const int mi = i >> 10, k = i & 1023; const float v = (mi < 8) ? c_in[mi * 1024 + k] : cctx_in[k]; sl[i] = silu_f(v); }
            __syncthreads();
            for (int it = bx; it < 4 * 96; it += G) {
                const int l = it / 96, n0 = (it % 96) * 64;
                const float* W = AIN(4) + (size_t)l * 1024 * 6144 + n0 + lane;
                float a[9];
#pragma unroll
                for (int mi = 0; mi < 9; ++mi) a[mi] = 0.f;
                for (int k0 = wave * 128; k0 < wave * 128 + 128; k0 += 16) { float wv[16];
#pragma unroll
                    for (int kk = 0; kk < 16; ++kk) wv[kk] = W[(size_t)(k0 + kk) * 6144];
#pragma unroll
                    for (int kk = 0; kk < 16; ++kk)
#pragma unroll
                        for (int mi = 0; mi < 9; ++mi) a[mi] += sl[mi * 1024 + k0 + kk] * wv[kk]; }
#pragma unroll
                for (int mi = 0; mi < 9; ++mi) part[(wave * 9 + mi) * 64 + lane] = a[mi];
                __syncthreads();
                for (int i = tid; i < 576; i += 512) { const int mi = i >> 6, n = i & 63; float s = 0.f;
#pragma unroll
                    for (int w = 0; w < 8; ++w) s += part[(w * 9 + mi) * 64 + n];
                    modv[((size_t)l * 9 + mi) * 6144 + n0 + n] = s + AIN(5)[l * 6144 + n0 + n]; }
                __syncthreads();
            }
            for (int i = gtid; i < NB * CTXL * DM / 4; i += NGT) ((f32x4*)xc_ws)[i] = ((const f32x4*)ctx_in)[i];
            for (int i = gtid; i < 64 * 16; i += NGT) { const int pos = i >> 4, f = i & 15; const float inv = __builtin_amdgcn_exp2f(-(float)f * (13.287712379549449f / 16.0f));
                float tr = (float)pos * inv * 0.15915494309189535f; tr -= floorf(tr); ropeA[2 * i] = __builtin_amdgcn_cosf(tr); ropeA[2 * i + 1] = __builtin_amdgcn_sinf(tr); }
            for (int i = gtid; i < 64 * 32; i += NGT) { const int pos = i >> 5, f = i & 31; const float inv = __builtin_amdgcn_exp2f(-(float)f * (13.287712379549449f / 32.0f));
                float tr = (float)pos * inv * 0.15915494309189535f; tr -= floorf(tr); ropeB[2 * i] = __builtin_amdgcn_cosf(tr); ropeB[2 * i + 1] = __builtin_amdgcn_sinf(tr); }
            bf16_t* csctx = (bf16_t*)(ws + WS_CSCTX); bf16_t* dc = (bf16_t*)(ws + WS_DC);
            for (int i = gtid; i < 256 * 256; i += NGT) { const int r = i >> 8, n = i & 255, half = (r >> 7) & 1; int k = r & 127; int hf = half; if (half && k == 0) { k = 128; hf = 0; }
                const float tr = (float)((k * n) & 255) * (1.0f / 256.0f); const float v = (hf ? __builtin_amdgcn_sinf(tr) : __builtin_amdgcn_cosf(tr)) * 0.0625f; csctx[i] = (bf16_t)f2bf(v); }
            for (int i = gtid; i < 256 * 512; i += NGT) { const int j = i >> 9, col = i & 511, cs = col >> 8, cch = col & 255;
                const float tr = (float)((cch * j) & 255) * (1.0f / 256.0f); const float v = (cs ? -__builtin_amdgcn_sinf(tr) : __builtin_amdgcn_cosf(tr)) * 0.0625f; dc[i] = (bf16_t)f2bf(v); }
        } break;
        case K_NM_MIX: case K_NM_FFN: {
            const float* ln = (kind == K_NM_MIX ? AIN(6) : AIN(7)) + layer * 1024; const int chunk = (kind == K_NM_MIX) ? 0 : 3;
            if (!(last && kind == K_NM_FFN)) {
                int pS = 0; const float* pP = nullptr; const float* pg = nullptr; const float* pb = nullptr;
                if (kind == K_NM_FFN) { pS = 4; pP = (const float*)R1; pg = modl + 8 * 6144 + 2 * 1024; pb = (mixer == 2) ? AIN(19) : nullptr; }
                else if (layer == 1 || layer == 3) { pS = 11; pP = (const float*)R2; pg = modv + (size_t)(layer - 1) * 9 * 6144 + 8 * 6144 + 5 * 1024; }
                const float* sh = modl + 8 * 6144 + chunk * 1024; const float* sc = sh + 1024;
                for (int cr = gw; cr < NB * CTXL; cr += NGW) {
                    f32x4* xr = (f32x4*)(xc_ws + (size_t)cr * DM); f32x4 v[4];
#pragma unroll
                    for (int j = 0; j < 4; ++j) v[j] = xr[lane + 64 * j];
                    if (pS) { f32x4 a4[4];
#pragma unroll
                        for (int j = 0; j < 4; ++j) a4[j] = pb ? ((const f32x4*)pb)[lane + 64 * j] : (f32x4){0.f, 0.f, 0.f, 0.f};
                        for (int s = 0; s < pS; ++s) { const f32x4* pr = (const f32x4*)(pP + ((size_t)s * (NB * CTXL) + cr) * DM);
#pragma unroll
                            for (int j = 0; j < 4; ++j) a4[j] += pr[lane + 64 * j]; }
#pragma unroll
                        for (int j = 0; j < 4; ++j) { v[j] += ((const f32x4*)pg)[lane + 64 * j] * a4[j]; xr[lane + 64 * j] = v[j]; } }
                    float ss = 0.f;
#pragma unroll
                    for (int j = 0; j < 4; ++j) ss += (v[j].x * v[j].x + v[j].y * v[j].y) + (v[j].z * v[j].z + v[j].w * v[j].w);
                    const float rstd = __builtin_amdgcn_rsqf(wave_sum(ss) * (1.0f / DM) + EPS);
                    u32x2* o8 = (u32x2*)(R3 + ((size_t)(cr >> 8) * RPB + (cr & 255)) * DM) + lane;
#pragma unroll
                    for (int j = 0; j < 4; ++j) { const f32x4 y = v[j] * rstd * (((const f32x4*)ln)[lane + 64 * j] * (((const f32x4*)sc)[lane + 64 * j] + 1.0f)) + ((const f32x4*)sh)[lane + 64 * j];
                        u32x2 w; w.x = cvt_pk_bf16(y.x, y.y); w.y = cvt_pk_bf16(y.z, y.w); o8[64 * j] = w; }
                }
            }
            const bool nm_fused = fuse_ok && (kind == K_NM_FFN || layer == 1 || layer == 3);
            const int NLAT = nm_fused ? 0 : NB * SEQ, rpw = (((NB * SEQ + NGW - 1) / NGW) + 3) & ~3, r0 = gw * rpw, r1 = (r0 + rpw < NLAT) ? r0 + rpw : NLAT;
            f32x4 v[4][4] = {}, vn[4][4] = {}, Am[4] = {}, Bm[4] = {}; int cur_mi = -1;
#pragma unroll
            for (int q = 0; q < 4; ++q) if (r0 + q < r1) { const float* xr = xl_cur + (size_t)(r0 + q) * DM;
#pragma unroll
                for (int j = 0; j < 4; ++j) v[q][j] = ((const f32x4*)xr)[lane + 64 * j]; }
            for (int row = r0; row < r1; row += 4) {
#pragma unroll
                for (int q = 0; q < 4; ++q) if (row + 4 + q < r1) { const float* xr = xl_cur + (size_t)(row + 4 + q) * DM;
#pragma unroll
                    for (int j = 0; j < 4; ++j) vn[q][j] = ((const f32x4*)xr)[lane + 64 * j]; }
                const int mi = row >> 12;
                if (mi != cur_mi) { cur_mi = mi; const float* sh = modl + mi * 6144 + chunk * 1024; const float* sc = sh + 1024;
#pragma unroll
                    for (int j = 0; j < 4; ++j) { Am[j] = ((const f32x4*)ln)[lane + 64 * j] * (((const f32x4*)sc)[lane + 64 * j] + 1.0f); Bm[j] = ((const f32x4*)sh)[lane + 64 * j]; } }
                float rstd[4];
#pragma unroll
                for (int q = 0; q < 4; ++q) { float ss = 0.f;
#pragma unroll
                    for (int j = 0; j < 4; ++j) ss += (v[q][j].x * v[q][j].x + v[q][j].y * v[q][j].y) + (v[q][j].z * v[q][j].z + v[q][j].w * v[q][j].w);
                    rstd[q] = __builtin_amdgcn_rsqf(wave_sum(ss) * (1.0f / DM) + EPS); }
#pragma unroll
                for (int q = 0; q < 4; ++q) if (row + q < r1) { u32x2* o8 = (u32x2*)(R3 + ((size_t)mi * RPB + CTXL + ((row + q) & 4095)) * DM) + lane;
#pragma unroll
                    for (int j = 0; j < 4; ++j) { const f32x4 y = v[q][j] * rstd[q] * Am[j] + Bm[j]; u32x2 w; w.x = cvt_pk_bf16(y.x, y.y); w.y = cvt_pk_bf16(y.z, y.w); o8[64 * j] = w; } }
#pragma unroll
                for (int q = 0; q < 4; ++q)
#pragma unroll
                    for (int j = 0; j < 4; ++j) v[q][j] = vn[q][j];
            }
        } break;
        case K_NM_T: {
            const float* ln = AIN(6) + layer * 1024;
            LAS bf16_t* tile = (LAS bf16_t*)lds;
            bf16_t* HTl = R3; bf16_t* HTc = (bf16_t*)((unsigned char*)R3 + R3_HTC_OFF);
            for (int it = bx; it < MROWS / 64; it += G) {
                const int row0 = it * 64, b = row0 / RPB, t0 = row0 - b * RPB; const bool isc = t0 < CTXL;
                const float* sh = modl + (isc ? 8 : b) * 6144; const float* sc = sh + 1024;
                float Ac[16], Bc[16], v[16], vn[16] = {};
#pragma unroll
                for (int j = 0; j < 16; ++j) { const int col = lane + 64 * j; Ac[j] = ln[col] * (sc[col] + 1.0f); Bc[j] = sh[col]; }
                { const int t = t0 + wave * 8; const float* xr = isc ? xc_cur + (size_t)(b * CTXL + t) * DM : xl_cur + (size_t)(b * SEQ + t - CTXL) * DM;
#pragma unroll
                  for (int j = 0; j < 16; ++j) v[j] = xr[lane + 64 * j]; }
                const float* pgT = modv + (size_t)(layer - 1) * 9 * 6144 + 8 * 6144 + 5 * 1024;
                for (int i = 0; i < 8; ++i) { const int rr = wave * 8 + i;
                    if (isc) { const int cr = b * CTXL + t0 + rr; const float* p0 = (const float*)R2 + (size_t)cr * DM; const float* p1 = p0 + (size_t)NB * CTXL * DM; float* xw = xc_ws + (size_t)cr * DM;
#pragma unroll
                        for (int j = 0; j < 16; ++j) { const int col = lane + 64 * j; v[j] += pgT[col] * (p0[col] + p1[col]); xw[col] = v[j]; } }
                    if (i + 1 < 8) { const int t = t0 + rr + 1; const float* xr = isc ? xc_cur + (size_t)(b * CTXL + t) * DM : xl_cur + (size_t)(b * SEQ + t - CTXL) * DM;
#pragma unroll
                        for (int j = 0; j < 16; ++j) vn[j] = xr[lane + 64 * j]; }
                    float ss = 0.f;
#pragma unroll
                    for (int j = 0; j < 16; ++j) ss += v[j] * v[j];
                    const float rstd = __builtin_amdgcn_rsqf(wave_sum(ss) * (1.0f / DM) + EPS);
#pragma unroll
                    for (int j = 0; j < 16; ++j) { const float y = v[j] * rstd * Ac[j] + Bc[j]; tile[(lane + 64 * j) * 66 + rr] = (bf16_t)f2bf(y); }
#pragma unroll
                    for (int j = 0; j < 16; ++j) v[j] = vn[j]; }
                __syncthreads();
                for (int idx = tid; idx < 1024 * 32; idx += 512) { const int cch = idx >> 5, tp = idx & 31; const unsigned w = *(const LAS unsigned*)(tile + cch * 66 + 2 * tp);
                    bf16_t* dst = isc ? HTc + ((size_t)(b * 1024 + cch) * CTXL + t0 + 2 * tp) : HTl + ((size_t)(b * 1024 + cch) * SEQ + (t0 - CTXL) + 2 * tp);
                    *(unsigned*)dst = w; }
                __syncthreads();
            }
            bf16_t* CS = (bf16_t*)((unsigned char*)R2 + R2_CS_OFF);
            for (int idx = gtid; idx < 4096 * 512; idx += NGT) { const int r = idx >> 9, n0 = (idx & 511) * 8; int half = (r >> 7) & 1, k = (r >> 8) * 128 + (r & 127); if (half && k == 0) { k = 2048; half = 0; }
                float vv[8];
#pragma unroll
                for (int e = 0; e < 8; ++e) { const float tr = (float)((k * (n0 + e)) & 4095) * (1.0f / 4096.0f); vv[e] = (half ? __builtin_amdgcn_sinf(tr) : __builtin_amdgcn_cosf(tr)) * 0.015625f; }
                u32x4 w; w.x = cvt_pk_bf16(vv[0], vv[1]); w.y = cvt_pk_bf16(vv[2], vv[3]); w.z = cvt_pk_bf16(vv[4], vv[5]); w.w = cvt_pk_bf16(vv[6], vv[7]);
                *(u32x4*)(CS + (size_t)r * 4096 + n0) = w; }
        } break;
        case K_G_QKV: {
            if (mixer == 0) { gd = pg8::Gemm{R3, (const bf16_t*)(ws + WS_WQKVA) + (size_t)mj * 3072 * 1024, 1024, 1024, 1024, 0, 0}; gS.init(MROWS / 256, 12, 1, G, bx); eS = pg8::EpiStore{R1, 3072, 0, ropeA, 8}; }
            else { gd = pg8::Gemm{R3, (const bf16_t*)(ws + WS_WQKVB), 1024, 1024, 1024, 0, 0}; gS.init(MROWS / 256, 6, 1, G, bx); eS = pg8::EpiStore{R1, 1536, 0, nullptr, 0}; }
            gk = 1;
        } break;
        case K_G_CH: {
            gS.init(MROWS / 256, 1, 4, G, bx);
            gd = pg8::Gemm{R1, (const bf16_t*)(ws + WS_DC), 2048, 512, 512, 512 * 2, 0};
            eS = pg8::EpiStore{R2, 1024, 256, nullptr, 0}; gk = 1;
        } break;
        case K_G_POS: gk = 4; break;
        case K_G_OUT: {
            const bf16_t* A = (mixer == 0) ? R3 : R2;
            const bf16_t* W = (mixer == 0) ? (const bf16_t*)(ws + WS_WOA) + (size_t)mj * 1024 * 1024 : (mixer == 1) ? (const bf16_t*)(ws + WS_WOB) : (const bf16_t*)(ws + WS_WOC);
            gS.init(128, 4, 1, G, bx, 2);
            gd = pg8::Gemm{A, W, 1024, 1024, 1024, 0, 0};
            eR = pg8::EpiResid{xl_cur, xc_cur, xl_ws, xc_ws, modl + 2 * 1024, (mixer == 2) ? AIN(19) : nullptr, nullptr,
                               fuse_ok ? 1 : 0, R3, AIN(7) + layer * 1024, modl + 3 * 1024, (float*)(ws + WS_XBUF), (unsigned*)(ws + WS_CNT) + (size_t)(layer * 2) * 128 * 64, lds + pg8::STAGE_BYTES}; gk = 2;
            if (!last) { gS2.init(8, 4, 4, G, bx, 1); gd2 = pg8::Gemm{A, W, 1024, 1024, 256, 512, 512}; gk2 = 1; part2 = (float*)R1; }
        } break;
        case K_G_GU: {
            if (last) gS.init(128, 22, 1, G, bx, 2); else gS.init(MROWS / 256, 22, 1, G, bx);
            gd = pg8::Gemm{R3, (const bf16_t*)(ws + WS_WGU) + (size_t)layer * 5632 * 1024, 1024, 1024, 1024, 0, 0}; gk = 3;
        } break;
        case K_G_DOWN: {
            const bf16_t* W = (const bf16_t*)(ws + WS_WDN) + (size_t)layer * 1024 * 2816;
            gS.init(128, 4, 1, G, bx, 2);
            gd = pg8::Gemm{R1, W, 2816, 2816, 2816, 0, 0};
            eR = pg8::EpiResid{xl_ws, xc_ws, xl_ws, xc_ws, modl + 5 * 1024, nullptr, nullptr,
                               (!fuse_ok || layer == 1) ? 0 : (last ? 2 : 1), R3, last ? AIN(20) : AIN(6) + (layer + 1) * 1024, modv + (size_t)(layer + 1) * 9 * 6144, (float*)(ws + WS_XBUF),
                               (unsigned*)(ws + WS_CNT) + (size_t)(layer * 2 + 1) * 128 * 64, lds + pg8::STAGE_BYTES}; gk = 2;
            if (layer == 0 || layer == 2) { gS2.init(8, 4, 11, G, bx, 1); gd2 = pg8::Gemm{R1, W, 2816, 2816, 256, 512, 512}; gk2 = 1; part2 = (float*)R2; }
            if (layer == 1) { gS2.init(8, 4, 2, G, bx, 1); gd2 = pg8::Gemm{R1, W, 2816, 2816, 1408, 2816, 2816}; gk2 = 1; part2 = (float*)R2; }
        } break;
        case K_QKPOST: {
            const float* qn = AIN(15); const float* kn = AIN(16);
            const int rpw = (MROWS + NGW - 1) / NGW, r0 = gw * rpw, r1 = (r0 + rpw < MROWS) ? r0 + rpw : MROWS;
            const int wi = (lane & 15) * 8, p0 = (lane & 15) * 4, f0 = p0 & 31;
            const float qsc = 0.088388347648318440f * 1.4426950408889634f;
            const f32x4 gq0 = *(const f32x4*)(qn + wi) * qsc, gq1 = *(const f32x4*)(qn + wi + 4) * qsc, gk0 = *(const f32x4*)(kn + wi), gk1 = *(const f32x4*)(kn + wi + 4);
            for (int row = r0; row < r1; row += 4) {
                u32x4 w[4][3]; f32x4 c0[4], c1[4];
#pragma unroll
                for (int q = 0; q < 4; ++q) { const int rq = (row + q < r1) ? row + q : r1 - 1;
                    const int b = rq / RPB, t = rq - b * RPB; const bool isc = t < CTXL; const int tl = isc ? 0 : t - CTXL, rp = tl >> 6, cp = tl & 63, pos = (p0 < 32) ? rp : cp;
#pragma unroll
                    for (int j = 0; j < 3; ++j) w[q][j] = *(const u32x4*)(R1 + (size_t)rq * 1536 + (j * 64 + lane) * 8);
                    c0[q] = *(const f32x4*)(ropeB + (pos * 32 + f0) * 2); c1[q] = *(const f32x4*)(ropeB + (pos * 32 + f0) * 2 + 4);
                    if (isc) { c0[q] = (f32x4){1.f, 0.f, 1.f, 0.f}; c1[q] = c0[q]; } }
#pragma unroll
                for (int q = 0; q < 4; ++q) if (row + q < r1) { const f32x4 cs0 = c0[q], cs1 = c1[q];
#pragma unroll
                    for (int j = 0; j < 3; ++j) { const int head = (j * 64 + lane) >> 4; const u32x4 ww = w[q][j];
                        float xv[8] = {bflo(ww.x), bfhi(ww.x), bflo(ww.y), bfhi(ww.y), bflo(ww.z), bfhi(ww.z), bflo(ww.w), bfhi(ww.w)};
                        float ss = 0.f;
#pragma unroll
                        for (int e = 0; e < 8; ++e) ss += xv[e] * xv[e];
                        const float rstd = __builtin_amdgcn_rsqf(sum16(ss) * (1.0f / 128.0f) + EPS);
                        const f32x4 g0 = (head < 8) ? gq0 : gk0, g1 = (head < 8) ? gq1 : gk1;
                        const float a0 = xv[0] * rstd * g0.x, a1 = xv[1] * rstd * g0.y, b0 = xv[2] * rstd * g0.z, b1 = xv[3] * rstd * g0.w;
                        const float e0 = xv[4] * rstd * g1.x, e1 = xv[5] * rstd * g1.y, d0 = xv[6] * rstd * g1.z, d1 = xv[7] * rstd * g1.w;
                        u32x4 o; o.x = cvt_pk_bf16(a0 * cs0.x - a1 * cs0.y, a0 * cs0.y + a1 * cs0.x); o.y = cvt_pk_bf16(b0 * cs0.z - b1 * cs0.w, b0 * cs0.w + b1 * cs0.z);
                        o.z = cvt_pk_bf16(e0 * cs1.x - e1 * cs1.y, e0 * cs1.y + e1 * cs1.x); o.w = cvt_pk_bf16(d0 * cs1.z - d1 * cs1.w, d0 * cs1.w + d1 * cs1.z);
                        if (head < 10) *(u32x4*)(R1 + (size_t)(row + q) * 1536 + (j * 64 + lane) * 8) = o; } }
            }
        } break;
        case K_ATTN: {
            char* albs = (char*)lds_raw;
            const bool need_ctx = (layer != 3);
            const int gx = (G % 8 == 0) ? G / 8 : G, xcd = (G % 8 == 0) ? bx % 8 : 0, vl = (G % 8 == 0) ? bx / 8 : bx, nxc = (G % 8 == 0) ? 8 : 1;
            if (mixer == 0) {
                const float C = 0.125f * 1.4426950408889634f, thr = 8.f / 0.125f;
                const float* lv = AIN(11) + mj * 256; const float* sg = AIN(12) + mj * 128;
                const float linit = (layer == 0) ? LAMINIT0 : LAMINIT3;
                const float sa = wave_sum(lv[lane] * lv[64 + lane]), sb = wave_sum(lv[128 + lane] * lv[192 + lane]);
                const float lam = __expf(sa) - __expf(sb) + linit;
                const int per_x = 1024 / nxc, nlat = (per_x - vl + gx - 1) / gx, nctx = need_ctx ? (64 - bx + G - 1) / G : 0;
                bf16x8 pfv0 = {}, pfv1 = {}, pfk0 = {}; const int nunits = 2 * (nlat + (nctx > 0 ? nctx : 0));
                for (int i2 = 0; i2 < nunits; ++i2) {
                    const int i = i2 >> 1, comp = i2 & 1;
                    int b, h, seq; size_t qrow;
                    if (i < nlat) { const int U = xcd * per_x + vl + i * gx, bh = U >> 4; b = bh >> 3; h = bh & 7; qrow = (size_t)b * RPB + CTXL + (U & 15) * 256; seq = RPB; }
                    else { const int bh = bx + (i - nlat) * G; b = bh >> 3; h = bh & 7; qrow = (size_t)b * RPB; seq = CTXL; }
                    const size_t krow = (size_t)b * RPB;
                    int nbh = -1;
                    if (comp == 0) nbh = b * 8 + h;
                    else if (i2 + 1 < nunits) { const int i1 = i + 1; nbh = (i1 < nlat) ? ((xcd * per_x + vl + i1 * gx) >> 4) : bx + (i1 - nlat) * G; }
#ifndef NO_ATTN4
                    att::attn_unit<4, 3072, 3072, 1024>(R1 + qrow * 3072 + h * 128 + comp * 64, R1 + krow * 3072 + 1024 + h * 128, R1 + krow * 3072 + 2048 + h * 128,
                                                        R3 + qrow * 1024 + h * 128, seq, comp * 128, C, thr, albs, 1 + comp, sg, lam, 1.0f - linit, pfv0, pfv1, pfk0, i2 > 0, R1, nbh, comp ? 0 : 128);
#endif
                }
            } else {
                const float sc_ = 0.088388347648318440f; const float C = sc_ * 1.4426950408889634f, thr = 8.f / sc_;
                const int per_x = 1024 / nxc, nlat = (per_x - vl + gx - 1) / gx, nctx = need_ctx ? (64 - bx + G - 1) / G : 0;
                bf16x8 pg0 = {}, pg1 = {}, pg2 = {};
                for (int i = 0; i < nlat + (nctx > 0 ? nctx : 0); ++i) {
                    int b, qh, kvh, seq; size_t qrow;
                    if (i < nlat) { const int U = xcd * per_x + vl + i * gx, combo = U >> 6, k = U & 63; b = combo >> 1; kvh = combo & 1; qh = kvh * 4 + (k >> 4); qrow = (size_t)b * RPB + CTXL + (k & 15) * 256; seq = RPB; }
                    else { const int U = bx + (i - nlat) * G; b = U >> 3; qh = U & 7; kvh = qh >> 2; qrow = (size_t)b * RPB; seq = CTXL; }
                    const size_t krow = (size_t)b * RPB;
#ifndef NO_ATTN8
                    att::attn_unit<8, 1536, 1536, 1024>(R1 + qrow * 1536 + qh * 128, R1 + krow * 1536 + 1024 + kvh * 128, R1 + krow * 1536 + 1280 + kvh * 128,
                                                        R2 + qrow * 1024 + qh * 128, seq, 0, C, thr, albs, 0, nullptr, 0.f, 0.f, pg0, pg1, pg2, 0, nullptr, -1, 0);
#endif
                }
            }
        } break;
        case K_COMBINE: {
            const float* lv = AIN(11) + mj * 256; const float* sg = AIN(12) + mj * 128;
            const float linit = (layer == 0) ? LAMINIT0 : LAMINIT3;
            const float sa = wave_sum(lv[lane] * lv[64 + lane]), sb = wave_sum(lv[128 + lane] * lv[192 + lane]);
            const float lam = __expf(sa) - __expf(sb) + linit;
            const int wi = (lane & 15) * 8; const f32x4 g0 = *(const f32x4*)(sg + wi) * (1.0f - linit), g1 = *(const f32x4*)(sg + wi + 4) * (1.0f - linit);
            const int rpw = (MROWS + NGW - 1) / NGW, r0 = gw * rpw, r1 = (r0 + rpw < MROWS) ? r0 + rpw : MROWS;
            u32x4 q1[2] = {}, q2[2] = {}, n1[2] = {}, n2[2] = {};
            if (r0 < r1) {
#pragma unroll
                for (int j = 0; j < 2; ++j) { const int head = (j * 64 + lane) >> 4; q1[j] = *(const u32x4*)(R2 + (size_t)r0 * 2048 + head * 256 + wi); q2[j] = *(const u32x4*)(R2 + (size_t)r0 * 2048 + head * 256 + 128 + wi); } }
            for (int row = r0; row < r1; ++row) {
                if (row + 1 < r1) {
#pragma unroll
                    for (int j = 0; j < 2; ++j) { const int head = (j * 64 + lane) >> 4; n1[j] = *(const u32x4*)(R2 + (size_t)(row + 1) * 2048 + head * 256 + wi); n2[j] = *(const u32x4*)(R2 + (size_t)(row + 1) * 2048 + head * 256 + 128 + wi); } }
                const bool isc = (row % RPB) < CTXL;
                if (!(last && isc)) {
#pragma unroll
                for (int j = 0; j < 2; ++j) { const int head = (j * 64 + lane) >> 4; const u32x4 w1 = q1[j], w2 = q2[j];
                    float d[8] = {bflo(w1.x) - lam * bflo(w2.x), bfhi(w1.x) - lam * bfhi(w2.x), bflo(w1.y) - lam * bflo(w2.y), bfhi(w1.y) - lam * bfhi(w2.y),
                                  bflo(w1.z) - lam * bflo(w2.z), bfhi(w1.z) - lam * bfhi(w2.z), bflo(w1.w) - lam * bflo(w2.w), bfhi(w1.w) - lam * bfhi(w2.w)};
                    float ss = 0.f;
#pragma unroll
                    for (int e = 0; e < 8; ++e) ss += d[e] * d[e];
                    const float rstd = __builtin_amdgcn_rsqf(sum16(ss) * (1.0f / 128.0f) + EPS);
                    u32x4 o; o.x = cvt_pk_bf16(d[0] * rstd * g0.x, d[1] * rstd * g0.y); o.y = cvt_pk_bf16(d[2] * rstd * g0.z, d[3] * rstd * g0.w);
                    o.z = cvt_pk_bf16(d[4] * rstd * g1.x, d[5] * rstd * g1.y); o.w = cvt_pk_bf16(d[6] * rstd * g1.z, d[7] * rstd * g1.w);
                    *(u32x4*)(R3 + (size_t)row * DM + head * 128 + wi) = o; }
                }
#pragma unroll
                for (int j = 0; j < 2; ++j) { q1[j] = n1[j]; q2[j] = n2[j]; }
            }
        } break;
        case K_FINAL: {
            const float* fn = AIN(20);
            const int NLAT = fuse_ok ? 0 : NB * SEQ, rpw = (((NB * SEQ + NGW - 1) / NGW) + 3) & ~3, r0 = gw * rpw, r1 = (r0 + rpw < NLAT) ? r0 + rpw : NLAT;
            f32x4 v[4][4] = {}, vn[4][4] = {}, fw[4];
#pragma unroll
            for (int j = 0; j < 4; ++j) fw[j] = ((const f32x4*)fn)[lane + 64 * j];
#pragma unroll
            for (int q = 0; q < 4; ++q) if (r0 + q < r1) {
#pragma unroll
                for (int j = 0; j < 4; ++j) v[q][j] = ((const f32x4*)(xl_ws + (size_t)(r0 + q) * DM))[lane + 64 * j]; }
            for (int row = r0; row < r1; row += 4) {
#pragma unroll
                for (int q = 0; q < 4; ++q) if (row + 4 + q < r1) {
#pragma unroll
                    for (int j = 0; j < 4; ++j) vn[q][j] = ((const f32x4*)(xl_ws + (size_t)(row + 4 + q) * DM))[lane + 64 * j]; }
                float rstd[4];
#pragma unroll
                for (int q = 0; q < 4; ++q) { float ss = 0.f;
#pragma unroll
                    for (int j = 0; j < 4; ++j) ss += (v[q][j].x * v[q][j].x + v[q][j].y * v[q][j].y) + (v[q][j].z * v[q][j].z + v[q][j].w * v[q][j].w);
                    rstd[q] = __builtin_amdgcn_rsqf(wave_sum(ss) * (1.0f / DM) + EPS); }
#pragma unroll
                for (int q = 0; q < 4; ++q) if (row + q < r1) { f32x4* xr = (f32x4*)(xl_ws + (size_t)(row + q) * DM);
#pragma unroll
                    for (int j = 0; j < 4; ++j) xr[lane + 64 * j] = v[q][j] * rstd[q] * fw[j]; }
#pragma unroll
                for (int q = 0; q < 4; ++q)
#pragma unroll
                    for (int j = 0; j < 4; ++j) v[q][j] = vn[q][j];
            }
        } break;
        default: break;
        }
#ifndef NO_GEMM
        if (gk == 1) pg8::gemm_phase<pg8::EpiStore>(lds, gd, gS, eS);
        else if (gk == 2) {
            for (int it = 0; it < 1 + gk2; ++it) {
                const int rep = (gk2 && bx < 128) ? 1 - it : it;
                const pg8::Gemm g_ = rep ? gd2 : gd; const pg8::Order s_ = rep ? gS2 : gS; pg8::EpiResid e_ = eR; e_.part = rep ? part2 : nullptr;
                pg8::gemm_phase<pg8::EpiResid>(lds, g_, s_, e_);
            }
        }
        else if (gk == 3) { pg8::EpiSwiGLU E{R1}; pg8::gemm_phase<pg8::EpiSwiGLU>(lds, gd, gS, E); }
        else if (gk == 4) {
            for (int rep = 0; rep < 2; ++rep) {
                if (rep == 0) { gS.init(16, 4, 8, G, bx); gd = pg8::Gemm{(const bf16_t*)((unsigned char*)R2 + R2_CS_OFF), R3, 4096, 4096, 4096, 0, (size_t)1024 * 4096 * 2}; }
                else { gS.init(1, 4, 8, G, bx); gd = pg8::Gemm{(const bf16_t*)(ws + WS_CSCTX), (const bf16_t*)((unsigned char*)R3 + R3_HTC_OFF), 256, 256, 256, 0, (size_t)1024 * 256 * 2}; }
                pg8::EpiPosDft E{R1, rep == 0 ? CTXL : 0, rep == 0 ? SEQ : CTXL}; pg8::gemm_phase<pg8::EpiPosDft>(lds, gd, gS, E);
            }
        }
#endif
        if (sl_ + 1 < args.ph_hi) {
            if (MK_PER_PHASE || ka->ph_lo < 0) grid.sync();
            else { unsigned* bw = (unsigned*)(ka->ws + WS_BAR); xcd_barrier(bw, bar_st); }
        }
    }
}

extern "C" void kernel_launch(void* const* d_in, const int* in_sizes, int n_in, void* d_out, int out_size, void* d_ws, size_t ws_size, hipStream_t stream) {
    static int grid = 0;
    if (grid == 0) {
        if (n_in != 21 || in_sizes[0] != NB * SEQ * DM || out_size != NB * SEQ * DM || ws_size < WS_END) {
            fprintf(stderr, "kernel_launch: unexpected shapes: n_in %d in0 %d out %d ws %zu (need >= %zu)\n", n_in, n_in > 0 ? in_sizes[0] : -1, out_size, ws_size, (size_t)WS_END); grid = -1; return; }
        int dev = 0, cus = 0, per_cu = 0;
        if (hipGetDevice(&dev) != hipSuccess || hipDeviceGetAttribute(&cus, hipDeviceAttributeMultiprocessorCount, dev) != hipSuccess) { fprintf(stderr, "kernel_launch: device query failed\n"); grid = -1; return; }
        if (hipFuncSetAttribute((const void*)fwd_megakernel, hipFuncAttributeMaxDynamicSharedMemorySize, LDS_BYTES) != hipSuccess) { fprintf(stderr, "kernel_launch: hipFuncSetAttribute failed\n"); grid = -1; return; }
        if (hipOccupancyMaxActiveBlocksPerMultiprocessor(&per_cu, (const void*)fwd_megakernel, 512, LDS_BYTES) != hipSuccess || per_cu < 1) { fprintf(stderr, "kernel_launch: occupancy query gave %d\n", per_cu); per_cu = 1; }
        (void)hipGetLastError();
        grid = cus * 1;
    }
    if (grid < 0) return;
    if (hipMemsetAsync((char*)d_ws + WS_BAR, 0, 65536 + 8 * 128 * 64 * 4, stream) != hipSuccess) { fprintf(stderr, "kernel_launch: memset of barrier words failed\n"); return; }
    Args a{};
    for (int i = 0; i < 21; ++i) a.in[i] = (const float*)d_in[i];
    a.out = (float*)d_out; a.ws = (unsigned char*)d_ws;
#if MK_PER_PHASE
    for (int ph = 0; ph < N_PHASES; ++ph) {
        a.ph_lo = ph; a.ph_hi = ph + 1; void* kargs[] = {&a};
        hipError_t e = hipLaunchCooperativeKernel((const void*)fwd_megakernel, dim3(grid), dim3(512), kargs, LDS_BYTES, stream);
        if (e != hipSuccess) { fprintf(stderr, "kernel_launch: launch (phase %d) failed: %s (grid %d)\n", ph, hipGetErrorString(e), grid); break; }
    }
#else
#ifdef PROBE_MASK
    a.ph_lo = 0; a.ph_hi = 2 * N_PHASES;
#else
    a.ph_lo = 0; a.ph_hi = N_PHASES;
#endif
    void* kargs[] = {&a};
    hipError_t e = hipLaunchCooperativeKernel((const void*)fwd_megakernel, dim3(grid), dim3(512), kargs, LDS_BYTES, stream);
    if (e != hipSuccess) fprintf(stderr, "kernel_launch: cooperative launch failed: %s (grid %d)\n", hipGetErrorString(e), grid);
#endif
}
```

```cpp
#include <hip/hip_runtime.h>
#include <hip/hip_bf16.h>
#include <hip/hip_cooperative_groups.h>
#include <cstdio>
#include <cstdint>
namespace cg = cooperative_groups;

#ifndef MK_PER_PHASE
#define MK_PER_PHASE 0
#endif

constexpr int NB = 8, SEQ = 4096, DM = 1024, CTXL = 256, RPB = SEQ + CTXL  , MROWS = NB * RPB  ;
constexpr int DFF = 2816, NTILE_B = RPB / 256  ;
constexpr float EPS = 1e-6f;
constexpr float LAMINIT0 = 0.2f, LAMINIT3 = 0.55605820415564054f;

constexpr size_t MiB = 1u << 20;
constexpr size_t WS_MODV = 0;
constexpr size_t WS_ROPEA = 1 * MiB;
constexpr size_t WS_ROPEB = 1 * MiB + 65536;
constexpr size_t WS_CSCTX = 2 * MiB;
constexpr size_t WS_DC = 2 * MiB + 512 * 1024;
constexpr size_t WS_BAR = 3 * MiB;
constexpr size_t WS_CNT = 3 * MiB + 65536;
constexpr size_t WS_XBUF = 3 * MiB + 524288;
constexpr size_t WS_XC = 4 * MiB;
constexpr size_t WS_WQKVA = 12 * MiB;
constexpr size_t WS_WOA = 24 * MiB;
constexpr size_t WS_WQKVB = 28 * MiB;
constexpr size_t WS_WOB = 31 * MiB;
constexpr size_t WS_WOC = 33 * MiB;
constexpr size_t WS_WGU = 35 * MiB;
constexpr size_t WS_WDN = 79 * MiB;
constexpr size_t WS_R3 = 101 * MiB;
constexpr size_t WS_R2 = 169 * MiB;
constexpr size_t WS_R1 = 305 * MiB;
constexpr size_t WS_END = 509 * MiB;
constexpr size_t R2_CS_OFF = 68 * MiB;
constexpr size_t R3_HTC_OFF = 64 * MiB;

constexpr int LDS_BYTES = 147456;

typedef unsigned short bf16_t;
typedef short bf16x8 __attribute__((ext_vector_type(8)));
typedef short s16x4 __attribute__((ext_vector_type(4)));
typedef float f32x4 __attribute__((ext_vector_type(4)));
typedef float f32x2 __attribute__((ext_vector_type(2)));
typedef float f32x16 __attribute__((ext_vector_type(16)));
typedef unsigned u32x4 __attribute__((ext_vector_type(4)));
typedef unsigned u32x2 __attribute__((ext_vector_type(2)));
#define LAS __attribute__((address_space(3)))

__device__ __forceinline__ unsigned cvt_pk_bf16(float lo, float hi) { unsigned r; asm volatile("v_cvt_pk_bf16_f32 %0, %1, %2" : "=v"(r) : "v"(lo), "v"(hi)); return r; }
__device__ __forceinline__ unsigned f2bf(float f) { unsigned u = __builtin_bit_cast(unsigned, f); return (u + 0x7fffu + ((u >> 16) & 1u)) >> 16; }
__device__ __forceinline__ float bflo(unsigned u) { return __builtin_bit_cast(float, u << 16); }
__device__ __forceinline__ float bfhi(unsigned u) { return __builtin_bit_cast(float, u & 0xffff0000u); }
__device__ __forceinline__ int tid_l() { int t = threadIdx.x; asm volatile("" : "+v"(t)); return t; }
__device__ __forceinline__ float wave_sum(float v) {
#pragma unroll
    for (int o = 1; o < 64; o <<= 1) v += __shfl_xor(v, o);
    return v;
}
__device__ __forceinline__ float sum16(float v) { v += __shfl_xor(v, 1); v += __shfl_xor(v, 2); v += __shfl_xor(v, 4); v += __shfl_xor(v, 8); return v; }
__device__ __forceinline__ float silu_f(float g) { return g * __builtin_amdgcn_rcpf(1.0f + __builtin_amdgcn_exp2f(-1.4426950408889634f * g)); }

#ifndef SPLITK_CTX
#define SPLITK_CTX 1
#endif
namespace pg8 {
constexpr int BM = 256, BK = 64, HALF = 128, HTB = HALF * BK * 2, STAGE_BYTES = 8 * HTB, NXCD = 8, WGM = 4;
__device__ __forceinline__ int lds_byte(int r, int c) { const int st = (r >> 4) * 2 + (c >> 5), rr = r & 15, cc = c & 31, ob = rr * 64 + cc * 2; return st * 1024 + (ob ^ (((ob >> 9) & 1) << 5)); }
__device__ __forceinline__ void stage_rc(int b, int& R, int& C) { const int st = b / 1024, sb = b % 1024, swz = sb ^ (((sb >> 9) & 1) << 5); R = (st >> 1) * 16 + swz / 64; C = (st & 1) * 32 + (swz % 64) / 2; }
__device__ __forceinline__ int perm32(int rho) { const int n = rho >> 4, i = rho & 15; return 8 * (i >> 2) + 4 * n + (i & 3); }

struct Unit { int pm, pn, z; };
struct Gemm { const bf16_t* A; const bf16_t* Bt; int lda, ldb, K; size_t aZ, bZ; };

struct Order {
    int nM, nN, nZ, nwg, G, c, mode;
    __device__ void init(int nM_, int nN_, int nZ_, int G_, int c_, int mode_ = 0) { nM = nM_; nN = nN_; nZ = nZ_; nwg = nM * nN * nZ; G = G_; c = c_; mode = mode_; }
    __device__ bool next(int i, Unit& u) const {
        const long L = (long)i * G + c; if (L >= nwg) return false;
        int wgid = (int)L; { const int q = nwg / NXCD, r = nwg % NXCD, xcd = wgid % NXCD, off = wgid / NXCD; wgid = (xcd < r ? xcd * (q + 1) : r * (q + 1) + (xcd - r) * q) + off; }
        const int per = nM * nN; u.z = wgid / per; wgid -= u.z * per;
        const int nig = WGM * nN, gid = wgid / nig, fm = gid * WGM, gsz = (nM - fm) < WGM ? (nM - fm) : WGM;
        const int pm = fm + ((wgid % nig) % gsz); u.pn = (wgid % nig) / gsz;
        u.pm = (mode == 1) ? pm * NTILE_B : (mode == 2) ? pm + (pm >> 4) + 1 : pm; return true;
    }
};

struct EpiStore {
    bf16_t* O; int ldc; size_t oZ; const float* rope; int rope_tiles;
    __device__ __forceinline__ void operator()(f32x4 (&acc)[2][2][4][2], const Unit& u, int wr, int wc, int fr, int fq) const {
        bf16_t* base = O + (size_t)u.z * oZ + (size_t)(u.pm * BM + wr * 64 + fr) * ldc + u.pn * BM + wc * 32 + 8 * fq;
        const int tt = u.pm % NTILE_B; const bool do_rope = rope && u.pn < rope_tiles && tt != 0;
        const float qs = (rope && u.pn < 4) ? 0.125f * 1.4426950408889634f : 1.0f;
#pragma unroll
        for (int ai = 0; ai < 2; ++ai)
#pragma unroll
            for (int m = 0; m < 4; ++m) { bf16_t* rowp = base + (size_t)(ai * HALF + m * 16) * ldc;
                f32x4 cs0 = (f32x4){1.f, 0.f, 1.f, 0.f}, cs1 = cs0;
                if (do_rope) { const int tl = (tt - 1) * 256 + ai * HALF + wr * 64 + m * 16 + fr, pos = (wc & 1) ? (tl & 63) : (tl >> 6);
                    const float* tp = rope + (pos * 16 + 4 * fq) * 2; cs0 = *(const f32x4*)tp; cs1 = *(const f32x4*)(tp + 4); }
#pragma unroll
                for (int bj = 0; bj < 2; ++bj) { const f32x4 v0 = acc[ai][bj][m][0] * qs, v1 = acc[ai][bj][m][1] * qs;
                    u32x4 w; w.x = cvt_pk_bf16(v0[0] * cs0.x - v0[1] * cs0.y, v0[0] * cs0.y + v0[1] * cs0.x); w.y = cvt_pk_bf16(v0[2] * cs0.z - v0[3] * cs0.w, v0[2] * cs0.w + v0[3] * cs0.z);
                    w.z = cvt_pk_bf16(v1[0] * cs1.x - v1[1] * cs1.y, v1[0] * cs1.y + v1[1] * cs1.x); w.w = cvt_pk_bf16(v1[2] * cs1.z - v1[3] * cs1.w, v1[2] * cs1.w + v1[3] * cs1.z);
                    *(u32x4*)(rowp + bj * HALF) = w; } }
    }
};
struct EpiQkvNorm {
    static constexpr bool PREFETCH = false;
    bf16_t* O; const float* rope; const float* qn; const float* kn; LAS unsigned char* xl;
    __device__ __forceinline__ void operator()(f32x4 (&acc)[2][2][4][2], const Unit& u, int wr, int wc, int fr, int fq) const {
        bf16_t* base = O + (size_t)(u.pm * BM + wr * 64 + fr) * 1536 + u.pn * BM + wc * 32 + 8 * fq;
        const int tt = u.pm % NTILE_B; const bool nrm = u.pn < 5, do_rope = nrm && tt != 0;
        LAS float* P = (LAS float*)xl;
        if (nrm) {
#pragma unroll
            for (int ai = 0; ai < 2; ++ai)
#pragma unroll
                for (int bj = 0; bj < 2; ++bj)
#pragma unroll
                    for (int m = 0; m < 4; ++m) { const f32x4 a = acc[ai][bj][m][0], c = acc[ai][bj][m][1];
                        float s = (a[0] * a[0] + a[1] * a[1]) + (a[2] * a[2] + a[3] * a[3]) + (c[0] * c[0] + c[1] * c[1]) + (c[2] * c[2] + c[3] * c[3]);
                        s += __shfl_xor(s, 16); s += __shfl_xor(s, 32);
                        if (fq == 0) P[((ai * 2 + bj) * 128 + wr * 64 + m * 16 + fr) * 4 + wc] = s; }
        }
        asm volatile("s_waitcnt lgkmcnt(0)" ::: "memory"); __builtin_amdgcn_s_barrier(); asm volatile("" ::: "memory");
        f32x4 g0 = (f32x4){1.f, 1.f, 1.f, 1.f}, g1 = g0;
        if (nrm) { const float* gg = (u.pn < 4 ? qn : kn) + wc * 32 + 8 * fq; const float sc = (u.pn < 4) ? 0.088388347648318440f * 1.4426950408889634f : 1.0f;
            g0 = *(const f32x4*)gg * sc; g1 = *(const f32x4*)(gg + 4) * sc; }
#pragma unroll
        for (int ai = 0; ai < 2; ++ai)
#pragma unroll
            for (int m = 0; m < 4; ++m) { bf16_t* rowp = base + (size_t)(ai * HALF + m * 16) * 1536;
                f32x4 cs0 = (f32x4){1.f, 0.f, 1.f, 0.f}, cs1 = cs0;
                if (do_rope) { const int tl = (tt - 1) * 256 + ai * HALF + wr * 64 + m * 16 + fr, pos = (wc & 2) ? (tl & 63) : (tl >> 6);
                    const float* tp = rope + (pos * 32 + ((16 * wc + 4 * fq) & 31)) * 2; cs0 = *(const f32x4*)tp; cs1 = *(const f32x4*)(tp + 4); }
#pragma unroll
                for (int bj = 0; bj < 2; ++bj) { float rstd = 1.0f;
                    if (nrm) { const f32x4 q4 = *(const LAS f32x4*)(P + ((ai * 2 + bj) * 128 + wr * 64 + m * 16 + fr) * 4); rstd = __builtin_amdgcn_rsqf(((q4[0] + q4[1]) + (q4[2] + q4[3])) * (1.0f / 128.0f) + EPS); }
                    const f32x4 v0 = acc[ai][bj][m][0] * rstd * g0, v1 = acc[ai][bj][m][1] * rstd * g1;
                    u32x4 w; w.x = cvt_pk_bf16(v0[0] * cs0.x - v0[1] * cs0.y, v0[0] * cs0.y + v0[1] * cs0.x); w.y = cvt_pk_bf16(v0[2] * cs0.z - v0[3] * cs0.w, v0[2] * cs0.w + v0[3] * cs0.z);
                    w.z = cvt_pk_bf16(v1[0] * cs1.x - v1[1] * cs1.y, v1[0] * cs1.y + v1[1] * cs1.x); w.w = cvt_pk_bf16(v1[2] * cs1.z - v1[3] * cs1.w, v1[2] * cs1.w + v1[3] * cs1.z);
                    *(u32x4*)(rowp + bj * HALF) = w; } }
    }
};
struct EpiPosDft {
    static constexpr bool PREFETCH = false;
    bf16_t* T; int row_off; int N;
    __device__ __forceinline__ void operator()(f32x4 (&acc)[2][2][4][2], const Unit& u, int wr, int wc, int fr, int fq) const {
        const size_t rowb = (size_t)u.z * RPB + row_off; const int colb = u.pn * 512 + wc * 32 + 8 * fq;
#pragma unroll
        for (int ai = 0; ai < 2; ++ai)
#pragma unroll
            for (int m = 0; m < 4; ++m) { const int k = u.pm * HALF + wr * 64 + m * 16 + fr;
#pragma unroll
                for (int bj = 0; bj < 2; ++bj) { const f32x4 v0 = acc[ai][bj][m][0], v1 = acc[ai][bj][m][1];
                    u32x4 w; w.x = cvt_pk_bf16(v0[0], v0[1]); w.y = cvt_pk_bf16(v0[2], v0[3]); w.z = cvt_pk_bf16(v1[0], v1[1]); w.w = cvt_pk_bf16(v1[2], v1[3]);
                    const int col = colb + bj * HALF;
                    if (ai == 1 && k == 0) { const u32x4 zz = {0u, 0u, 0u, 0u};
                        *(u32x4*)(T + (rowb + N / 2) * 2048 + col) = w; *(u32x4*)(T + (rowb + N / 2) * 2048 + col + 256) = zz; *(u32x4*)(T + rowb * 2048 + col + 256) = zz; }
                    else { *(u32x4*)(T + (rowb + k) * 2048 + col + ai * 256) = w;
                        if (k != 0) { u32x4 wm = w; if (ai) { wm.x ^= 0x80008000u; wm.y ^= 0x80008000u; wm.z ^= 0x80008000u; wm.w ^= 0x80008000u; }
                            *(u32x4*)(T + (rowb + N - k) * 2048 + col + ai * 256) = wm; } } } }
    }
};
struct EpiSwiGLU {
    bf16_t* O;
    __device__ __forceinline__ void operator()(f32x4 (&acc)[2][2][4][2], const Unit& u, int wr, int wc, int fr, int fq) const {
        bf16_t* base = O + (size_t)(u.pm * BM + wr * 64 + fr) * DFF + u.pn * HALF + wc * 32 + 8 * fq;
#pragma unroll
        for (int ai = 0; ai < 2; ++ai)
#pragma unroll
            for (int m = 0; m < 4; ++m) { bf16_t* rowp = base + (size_t)(ai * HALF + m * 16) * DFF;
                const f32x4 g0 = acc[ai][0][m][0], g1 = acc[ai][0][m][1], u0 = acc[ai][1][m][0], u1 = acc[ai][1][m][1];
                u32x4 w; w.x = cvt_pk_bf16(silu_f(g0[0]) * u0[0], silu_f(g0[1]) * u0[1]); w.y = cvt_pk_bf16(silu_f(g0[2]) * u0[2], silu_f(g0[3]) * u0[3]);
                w.z = cvt_pk_bf16(silu_f(g1[0]) * u1[0], silu_f(g1[1]) * u1[1]); w.w = cvt_pk_bf16(silu_f(g1[2]) * u1[2], silu_f(g1[3]) * u1[3]);
                *(u32x4*)rowp = w; }
    }
};
struct EpiResid {
    const float* xin_l; const float* xin_c; float* xout_l; float* xout_c; const float* gate; const float* bias; float* part;
    int hmode; bf16_t* H; const float* nln; const float* nmod; float* xbuf; unsigned* cnt; LAS unsigned char* xl;
    __device__ __forceinline__ void operator()(f32x4 (&acc)[2][2][4][2], const Unit& u, int wr, int wc, int fr, int fq) const {
        const int b = u.pm / NTILE_B, tt = u.pm - b * NTILE_B; const bool isc = (tt == 0);
        const int col0 = u.pn * BM + wc * 32 + 8 * fq;
        if (part) {
            float* P = part + ((size_t)u.z * (NB * CTXL) + (size_t)b * CTXL + wr * 64 + fr) * DM + col0;
#pragma unroll
            for (int ai = 0; ai < 2; ++ai)
#pragma unroll
                for (int m = 0; m < 4; ++m) { const size_t ro = (size_t)(ai * HALF + m * 16) * DM;
#pragma unroll
                    for (int bj = 0; bj < 2; ++bj)
#pragma unroll
                        for (int n = 0; n < 2; ++n) *(f32x4*)(P + ro + bj * HALF + 4 * n) = acc[ai][bj][m][n]; }
            return;
        }
        const size_t rowbase = isc ? (size_t)b * CTXL : (size_t)b * SEQ + (size_t)(tt - 1) * 256;
        const float* xin = (isc ? xin_c : xin_l) + (rowbase + wr * 64 + fr) * DM; float* xout = (isc ? xout_c : xout_l) + (rowbase + wr * 64 + fr) * DM;
        const float* g = gate + (isc ? 8 : b) * 6144 + col0;
        if (bias) {
#pragma unroll
            for (int bj = 0; bj < 2; ++bj)
#pragma unroll
                for (int n = 0; n < 2; ++n) { const f32x4 bv = *(const f32x4*)(bias + col0 + bj * HALF + 4 * n);
#pragma unroll
                    for (int ai = 0; ai < 2; ++ai)
#pragma unroll
                        for (int m = 0; m < 4; ++m) acc[ai][bj][m][n] += bv; }
        }
        f32x4 gv[2][2];
#pragma unroll
        for (int bj = 0; bj < 2; ++bj)
#pragma unroll
            for (int n = 0; n < 2; ++n) gv[bj][n] = *(const f32x4*)(g + bj * HALF + 4 * n);
#pragma unroll
        for (int ai = 0; ai < 2; ++ai) {
            f32x4 xi[4][2][2];
#pragma unroll
            for (int m = 0; m < 4; ++m)
#pragma unroll
                for (int bj = 0; bj < 2; ++bj)
#pragma unroll
                    for (int n = 0; n < 2; ++n) xi[m][bj][n] = *(const f32x4*)(xin + (size_t)(ai * HALF + m * 16) * DM + col0 + bj * HALF + 4 * n);
            asm volatile("s_waitcnt vmcnt(0)" ::: "memory");
#pragma unroll
            for (int m = 0; m < 4; ++m)
#pragma unroll
                for (int bj = 0; bj < 2; ++bj)
#pragma unroll
                    for (int n = 0; n < 2; ++n) { acc[ai][bj][m][n] = xi[m][bj][n] + gv[bj][n] * acc[ai][bj][m][n];
                        if (hmode != 2) *(f32x4*)(xout + (size_t)(ai * HALF + m * 16) * DM + col0 + bj * HALF + 4 * n) = acc[ai][bj][m][n]; }
            asm volatile("" ::: "memory");
        }
        if (hmode == 0) return;
        LAS float* P = (LAS float*)xl; LAS float* S = (LAS float*)(xl + 4096);
        const int tid = tid_l(), lane = tid & 63, wid = tid >> 6, pmi = b * 16 + (tt - 1);
#pragma unroll
        for (int ai = 0; ai < 2; ++ai)
#pragma unroll
            for (int m = 0; m < 4; ++m) { float s = 0.f;
#pragma unroll
                for (int bj = 0; bj < 2; ++bj)
#pragma unroll
                    for (int n = 0; n < 2; ++n) { const f32x4 a = acc[ai][bj][m][n]; s += (a[0] * a[0] + a[1] * a[1]) + (a[2] * a[2] + a[3] * a[3]); }
                s += __shfl_xor(s, 16); s += __shfl_xor(s, 32);
                if (fq == 0) P[(ai * HALF + wr * 64 + m * 16 + fr) * 4 + wc] = s; }
        asm volatile("s_waitcnt lgkmcnt(0)" ::: "memory"); __builtin_amdgcn_s_barrier(); asm volatile("" ::: "memory");
        const int prow = wid * 32 + (lane & 31);
        if (lane < 32) { const f32x4 q4 = *(const LAS f32x4*)(P + prow * 4);
            __hip_atomic_store(xbuf + ((size_t)pmi * 256 + prow) * 4 + u.pn, (q4[0] + q4[1]) + (q4[2] + q4[3]), __ATOMIC_RELAXED, __HIP_MEMORY_SCOPE_AGENT); }
        asm volatile("s_waitcnt vmcnt(0)" ::: "memory");
        if (lane == 0) __hip_atomic_fetch_add(cnt + 64 * pmi, 1u, __ATOMIC_RELAXED, __HIP_MEMORY_SCOPE_AGENT);
        if (wid == 0) { unsigned sp = 0;
            while ((unsigned)__builtin_amdgcn_readfirstlane(__hip_atomic_load(cnt + 64 * pmi, __ATOMIC_RELAXED, __HIP_MEMORY_SCOPE_AGENT)) < 32u) { __builtin_amdgcn_s_sleep(1); if (++sp > (1u << 22)) break; }
            }
        asm volatile("s_waitcnt vmcnt(0) lgkmcnt(0)" ::: "memory"); __builtin_amdgcn_s_barrier(); asm volatile("" ::: "memory");
        if (lane < 32) { const float* sl4 = xbuf + ((size_t)pmi * 256 + prow) * 4; float tsum = 0.f;
#pragma unroll
            for (int t = 0; t < 4; ++t) tsum += __hip_atomic_load(sl4 + t, __ATOMIC_RELAXED, __HIP_MEMORY_SCOPE_AGENT);
            S[prow] = __builtin_amdgcn_rsqf(tsum * (1.0f / DM) + EPS); }
        asm volatile("s_waitcnt vmcnt(0) lgkmcnt(0)" ::: "memory"); __builtin_amdgcn_s_barrier(); asm volatile("" ::: "memory");
        int c0 = col0, rl = wr * 64 + fr; asm volatile("" : "+v"(c0), "+v"(rl));
        f32x4 Am[2][2], Bm[2][2];
#pragma unroll
        for (int bj = 0; bj < 2; ++bj)
#pragma unroll
            for (int n = 0; n < 2; ++n) { const int c = c0 + bj * HALF + 4 * n; const f32x4 l4 = *(const f32x4*)(nln + c);
                if (hmode == 1) { Am[bj][n] = l4 * (*(const f32x4*)(nmod + b * 6144 + 1024 + c) + 1.0f); Bm[bj][n] = *(const f32x4*)(nmod + b * 6144 + c); }
                else { Am[bj][n] = l4; Bm[bj][n] = (f32x4){0.f, 0.f, 0.f, 0.f}; } }
        bf16_t* hbase = H + ((size_t)u.pm * BM + rl) * DM + c0; float* obase = (isc ? xout_c : xout_l) + (rowbase + rl) * DM + c0;
#pragma unroll
        for (int ai = 0; ai < 2; ++ai)
#pragma unroll
            for (int m = 0; m < 4; ++m) { const int r = ai * HALF + m * 16; const float rs = S[r + rl];
                if (hmode == 1) {
#pragma unroll
                    for (int bj = 0; bj < 2; ++bj) { const f32x4 y0 = acc[ai][bj][m][0] * rs * Am[bj][0] + Bm[bj][0], y1 = acc[ai][bj][m][1] * rs * Am[bj][1] + Bm[bj][1];
                        u32x4 w; w.x = cvt_pk_bf16(y0[0], y0[1]); w.y = cvt_pk_bf16(y0[2], y0[3]); w.z = cvt_pk_bf16(y1[0], y1[1]); w.w = cvt_pk_bf16(y1[2], y1[3]);
                        *(u32x4*)(hbase + (size_t)r * DM + bj * HALF) = w; } }
                else {
#pragma unroll
                    for (int bj = 0; bj < 2; ++bj)
#pragma unroll
                        for (int n = 0; n < 2; ++n) *(f32x4*)(obase + (size_t)r * DM + bj * HALF + 4 * n) = acc[ai][bj][m][n] * rs * Am[bj][n]; } }
    }
};

template <class Epi>
__device__ __forceinline__ void gemm_phase(LAS unsigned char* lds, const Gemm g, const Order& S, const Epi& E) {
    const int tid = tid_l(), wid = __builtin_amdgcn_readfirstlane(tid >> 6), lane = tid & 63, wr = wid >> 2, wc = wid & 3, fr = lane & 15, fq = lane >> 4;
    const int K = g.K, nt = K / BK;
    unsigned voffA[2], voffB[2];
#pragma unroll
    for (int i = 0; i < 2; ++i) { int R, C; stage_rc(tid * 16 + i * 8192, R, C); const int Rb = (R & ~31) + perm32(R & 31);
        voffA[i] = (unsigned)(R * g.lda + C) * 2u; voffB[i] = (unsigned)(Rb * g.ldb + C) * 2u; }
    const size_t kstep = (size_t)(BK * 2);
    const size_t hsA = (size_t)HALF * g.lda * 2, hsB = (size_t)HALF * g.ldb * 2;
    const size_t tsA = 2 * hsA, tsB = 2 * hsB;
    const unsigned ldsw = (unsigned)wid * 1024u;
    const int aoff = lds_byte(wr * 64 + fr, fq * 8), boff = lds_byte(wc * 32 + fr, fq * 8);
#define PG8_SA(b, h) (((b) * 2 + (h)) * HTB)
#define PG8_SB(b, h) ((4 + (b) * 2 + (h)) * HTB)
#define PG8_STAGE(bufoff, gbase, voff) do { _Pragma("unroll") for (int _i = 0; _i < 2; ++_i) \
        __builtin_amdgcn_global_load_lds((const unsigned*)((const char*)(gbase) + (voff)[_i]), (LAS unsigned*)(lds + (bufoff) + ldsw + _i * 8192), 16, 0, 0); } while (0)
#define PG8_LDA(dst, b, h) do { _Pragma("unroll") for (int m = 0; m < 4; ++m) _Pragma("unroll") for (int k = 0; k < 2; ++k) dst[m][k] = *(const LAS bf16x8*)(lds + PG8_SA(b, h) + aoff + m * 2048 + k * 1024); } while (0)
#define PG8_LDB(dst, b, h) do { _Pragma("unroll") for (int n = 0; n < 2; ++n) _Pragma("unroll") for (int k = 0; k < 2; ++k) dst[n][k] = *(const LAS bf16x8*)(lds + PG8_SB(b, h) + boff + n * 2048 + k * 1024); } while (0)
#define PG8_MMA(ai, bj, At, Bt) do { __builtin_amdgcn_s_setprio(1); _Pragma("unroll") for (int m = 0; m < 4; ++m) _Pragma("unroll") for (int n = 0; n < 2; ++n) _Pragma("unroll") for (int k = 0; k < 2; ++k) \
        acc[ai][bj][m][n] = __builtin_amdgcn_mfma_f32_16x16x32_bf16(Bt[n][k], At[m][k], acc[ai][bj][m][n], 0, 0, 0); __builtin_amdgcn_s_setprio(0); } while (0)
#define PG8_WAIT_V(n) asm volatile("s_waitcnt vmcnt(" #n ")" ::: "memory")
#define PG8_WAIT_L(n) asm volatile("s_waitcnt lgkmcnt(" #n ")" ::: "memory")
#define PG8_BAR __builtin_amdgcn_s_barrier()
#define PG8_SCHED __builtin_amdgcn_sched_barrier(0)
    Unit cur, nxt; int ui = 0;
    if (!S.next(0, cur)) return;
    f32x4 acc[2][2][4][2];
#pragma unroll
    for (int a = 0; a < 2; ++a)
#pragma unroll
        for (int b = 0; b < 2; ++b)
#pragma unroll
            for (int m = 0; m < 4; ++m)
#pragma unroll
                for (int n = 0; n < 2; ++n) acc[a][b][m][n] = (f32x4){0.f, 0.f, 0.f, 0.f};
    bf16x8 At[4][2], B0[2][2], B1[2][2];
    const char* cA = (const char*)g.A + (size_t)cur.z * g.aZ + (size_t)cur.pm * tsA; const char* cB = (const char*)g.Bt + (size_t)cur.z * g.bZ + (size_t)cur.pn * tsB;
    PG8_STAGE(PG8_SB(0, 0), cB, voffB); PG8_STAGE(PG8_SB(0, 1), cB + hsB, voffB); PG8_STAGE(PG8_SA(0, 0), cA, voffA); PG8_STAGE(PG8_SA(0, 1), cA + hsA, voffA);
    if (wr == 1) PG8_BAR;
    PG8_WAIT_V(2); PG8_BAR;
    PG8_STAGE(PG8_SB(1, 0), cB + kstep, voffB); PG8_STAGE(PG8_SA(1, 0), cA + kstep, voffA); PG8_STAGE(PG8_SB(1, 1), cB + hsB + kstep, voffB);
    PG8_WAIT_V(6); PG8_BAR;
    for (;;) {
        const bool has_next = S.next(ui + 1, nxt);
        const char* nA = has_next ? (const char*)g.A + (size_t)nxt.z * g.aZ + (size_t)nxt.pm * tsA : cA; const char* nB = has_next ? (const char*)g.Bt + (size_t)nxt.z * g.bZ + (size_t)nxt.pn * tsB : cB;
        for (int t = 0; t < nt; t += 2) {
            const bool last = (t == nt - 2);
            const char* a1 = cA + (size_t)(t + 1) * kstep;
            const char* a2 = last ? nA : cA + (size_t)(t + 2) * kstep; const char* b2 = last ? nB : cB + (size_t)(t + 2) * kstep;
            const char* a3 = a2 + kstep; const char* b3 = b2 + kstep;
            PG8_LDB(B0, 0, 0); PG8_LDB(B1, 0, 1); PG8_SCHED; PG8_LDA(At, 0, 0); PG8_STAGE(PG8_SA(1, 1), a1 + hsA, voffA);
            PG8_WAIT_V(8); PG8_WAIT_L(0); PG8_BAR; PG8_MMA(0, 0, At, B0); PG8_MMA(0, 1, At, B1); PG8_BAR; PG8_SCHED;
            PG8_LDA(At, 0, 1); PG8_STAGE(PG8_SB(0, 0), b2, voffB); PG8_STAGE(PG8_SB(0, 1), b2 + hsB, voffB); PG8_STAGE(PG8_SA(0, 0), a2, voffA);
            PG8_WAIT_V(8); PG8_WAIT_L(0); PG8_BAR; PG8_MMA(1, 0, At, B0); PG8_MMA(1, 1, At, B1); PG8_BAR; PG8_SCHED;
            PG8_LDB(B0, 1, 0); PG8_LDB(B1, 1, 1); PG8_SCHED; PG8_LDA(At, 1, 0); PG8_STAGE(PG8_SA(0, 1), a2 + hsA, voffA);
            PG8_WAIT_V(8); PG8_WAIT_L(0); PG8_BAR; PG8_MMA(0, 0, At, B0); PG8_MMA(0, 1, At, B1); PG8_BAR; PG8_SCHED;
            PG8_LDA(At, 1, 1); PG8_STAGE(PG8_SB(1, 0), b3, voffB); PG8_STAGE(PG8_SB(1, 1), b3 + hsB, voffB); PG8_STAGE(PG8_SA(1, 0), a3, voffA);
            PG8_WAIT_V(8); PG8_WAIT_L(0); PG8_BAR; PG8_MMA(1, 0, At, B0); PG8_MMA(1, 1, At, B1); PG8_BAR; PG8_SCHED;
        }
        if (wr == 0) PG8_BAR;
        E(acc, cur, wr, wc, fr, fq);
        if (!has_next) break;
#pragma unroll
        for (int a = 0; a < 2; ++a)
#pragma unroll
            for (int b = 0; b < 2; ++b)
#pragma unroll
                for (int m = 0; m < 4; ++m)
#pragma unroll
                    for (int n = 0; n < 2; ++n) acc[a][b][m][n] = (f32x4){0.f, 0.f, 0.f, 0.f};
        cur = nxt; cA = nA; cB = nB; ++ui;
        if (wr == 1) PG8_BAR;
    }
    PG8_WAIT_V(0);
    PG8_BAR;
#undef PG8_SA
#undef PG8_SB
#undef PG8_STAGE
#undef PG8_LDA
#undef PG8_LDB
#undef PG8_MMA
#undef PG8_WAIT_V
#undef PG8_WAIT_L
#undef PG8_BAR
#undef PG8_SCHED
}
}

namespace att {
constexpr int NW = 8, QBLK = 32, KVBLK = 64;
constexpr size_t SHM_V = KVBLK * 128 * 2, SHM_K = KVBLK * 128 * 2, SHM_ATTN = 2 * SHM_V + 2 * SHM_K + NW * 64 * 4;
#define KSWZ(row, colB) ((row) * 256 + ((colB) ^ (((row) & 7) << 4)))
#define SBAR() __builtin_amdgcn_sched_barrier(0)
__device__ __forceinline__ int crow(int r, int hi) { return (r & 3) + 8 * (r >> 2) + 4 * hi; }
__device__ __forceinline__ unsigned cvtpk(float lo, float hi) { unsigned r; asm volatile("v_cvt_pk_bf16_f32 %0, %1, %2" : "=v"(r) : "v"(lo), "v"(hi)); return r; }

__device__ __forceinline__ void partialSM(f32x16& p0, f32x16& p1, float& m_reg, float& mn, float& alpha, const float C, const float thr_raw) {
  float pmax = p0[0];
#pragma unroll
  for (int r = 1; r < 16; ++r) pmax = fmaxf(pmax, p0[r]);
#pragma unroll
  for (int r = 0; r < 16; ++r) pmax = fmaxf(pmax, p1[r]);
  { auto rr = __builtin_amdgcn_permlane32_swap(__float_as_uint(pmax), __float_as_uint(pmax), false, false);
    pmax = fmaxf(__uint_as_float(rr[0]), __uint_as_float(rr[1])); }
  if (__builtin_expect(__all(pmax - m_reg <= thr_raw), 1)) { mn = m_reg; alpha = 1.f; }
  else { mn = fmaxf(m_reg, pmax); alpha = __builtin_amdgcn_exp2f((m_reg - mn) * C); m_reg = mn; }
  float mnC = -mn * C;
#pragma unroll
  for (int r = 0; r < 16; ++r) p0[r] = fmaf(p0[r], C, mnC);
#pragma unroll
  for (int r = 0; r < 16; ++r) p1[r] = fmaf(p1[r], C, mnC);
#pragma unroll
  for (int r = 0; r < 16; ++r) p0[r] = __builtin_amdgcn_exp2f(p0[r]);
}
__device__ __forceinline__ void partialSM_pre(f32x16& p0, f32x16& p1, float& m_ref, float& alpha, const float thr2) {
  if (__builtin_expect(__any(m_ref != 0.f), 0)) {
#pragma unroll
    for (int r = 0; r < 16; ++r) { p0[r] -= m_ref; p1[r] -= m_ref; } }
  float pmax = p0[0];
#pragma unroll
  for (int r = 1; r < 16; ++r) pmax = fmaxf(pmax, p0[r]);
#pragma unroll
  for (int r = 0; r < 16; ++r) pmax = fmaxf(pmax, p1[r]);
  { auto rr = __builtin_amdgcn_permlane32_swap(__float_as_uint(pmax), __float_as_uint(pmax), false, false);
    pmax = fmaxf(__uint_as_float(rr[0]), __uint_as_float(rr[1])); }
  if (__builtin_expect(__all(pmax <= thr2), 1)) { alpha = 1.f; }
  else { const float dl = fmaxf(pmax, 0.f); m_ref += dl; alpha = __builtin_amdgcn_exp2f(-dl);
#pragma unroll
    for (int r = 0; r < 16; ++r) { p0[r] -= dl; p1[r] -= dl; } }
#pragma unroll
  for (int r = 0; r < 16; ++r) p0[r] = __builtin_amdgcn_exp2f(p0[r]);
}
__device__ __forceinline__ void finishSM(f32x16& p0, f32x16& p1, float alpha, float& l_reg, bf16x8& pa0, bf16x8& pa1, bf16x8& pa2, bf16x8& pa3) {
#pragma unroll
  for (int r = 0; r < 16; ++r) p1[r] = __builtin_amdgcn_exp2f(p1[r]);
  float ps = 0;
#pragma unroll
  for (int r = 0; r < 16; ++r) ps += p0[r];
#pragma unroll
  for (int r = 0; r < 16; ++r) ps += p1[r];
  { auto rr = __builtin_amdgcn_permlane32_swap(__float_as_uint(ps), __float_as_uint(ps), false, false);
    ps = __uint_as_float(rr[0]) + __uint_as_float(rr[1]); }
  l_reg = l_reg * alpha + ps;
#define PK4(P, BASE, OUT) do { unsigned a0 = cvtpk(P[BASE + 0], P[BASE + 1]), a1 = cvtpk(P[BASE + 2], P[BASE + 3]);   \
    unsigned b0 = cvtpk(P[BASE + 4], P[BASE + 5]), b1 = cvtpk(P[BASE + 6], P[BASE + 7]);                              \
    auto r0 = __builtin_amdgcn_permlane32_swap(a0, b0, false, false); auto r1 = __builtin_amdgcn_permlane32_swap(a1, b1, false, false); \
    u32x4 w = {r0[0], r1[0], r0[1], r1[1]}; OUT = *reinterpret_cast<bf16x8*>(&w); } while (0)
  PK4(p0, 0, pa0); PK4(p0, 8, pa1); PK4(p1, 0, pa2); PK4(p1, 8, pa3);
#undef PK4
}
template <int ND0>
__device__ __forceinline__ void qkt(f32x16& p0, f32x16& p1, const char* Ks, const bf16x8* qr, int r32, int hi) {
  p0 = f32x16{}; p1 = f32x16{};
#pragma unroll
  for (int d0 = 0; d0 < ND0; ++d0) { int cb = (d0 * 16 + hi * 8) * 2;
    bf16x8 b0 = *reinterpret_cast<const bf16x8*>(Ks + KSWZ(r32, cb));
    bf16x8 b1 = *reinterpret_cast<const bf16x8*>(Ks + KSWZ(32 + r32, cb));
    p0 = __builtin_amdgcn_mfma_f32_32x32x16_bf16(b0, qr[d0], p0, 0, 0, 0);
    p1 = __builtin_amdgcn_mfma_f32_32x32x16_bf16(b1, qr[d0], p1, 0, 0, 0); }
}
__device__ __forceinline__ int v_st(int k, int c) { const int kk = (k & ~0xC) | ((k & 4) << 1) | ((k & 8) >> 1); return ((kk >> 3) * 4 + (c >> 5)) * 512 + ((kk & 7) * 32 + (c & 31)) * 2; }
__device__ __forceinline__ int v_rd_base(int lane) { return ((lane & 3) << 3) | (((lane >> 2) & 3) << 6) | (((lane >> 4) & 1) << 5) | (((lane >> 5) & 1) << 8); }
constexpr int v_rd_off(int d0, int ks, int half) { return d0 * 512 + ks * 4096 + half * 2048; }
template <int OFF> __device__ __forceinline__ s16x4 tr_read(int vb) {
  s16x4 r; asm volatile("ds_read_b64_tr_b16 %0, %1 offset:%2" : "=&v"(r) : "v"(vb), "i"(OFF) : "memory"); return r;
}
template <int D0> __device__ __forceinline__ void pv_one(f32x16& od, int vb, bf16x8 pa0, bf16x8 pa1, bf16x8 pa2, bf16x8 pa3) {
  const s16x4 l0 = tr_read<v_rd_off(D0, 0, 0)>(vb), h0 = tr_read<v_rd_off(D0, 0, 1)>(vb), l1 = tr_read<v_rd_off(D0, 1, 0)>(vb), h1 = tr_read<v_rd_off(D0, 1, 1)>(vb);
  const s16x4 l2 = tr_read<v_rd_off(D0, 2, 0)>(vb), h2 = tr_read<v_rd_off(D0, 2, 1)>(vb), l3 = tr_read<v_rd_off(D0, 3, 0)>(vb), h3 = tr_read<v_rd_off(D0, 3, 1)>(vb);
  asm volatile("s_waitcnt lgkmcnt(0)" ::: "memory"); SBAR();
#define PK(L, H) (bf16x8){L[0], L[1], L[2], L[3], H[0], H[1], H[2], H[3]}
  od = __builtin_amdgcn_mfma_f32_32x32x16_bf16(pa0, PK(l0, h0), od, 0, 0, 0);
  od = __builtin_amdgcn_mfma_f32_32x32x16_bf16(pa1, PK(l1, h1), od, 0, 0, 0);
  od = __builtin_amdgcn_mfma_f32_32x32x16_bf16(pa2, PK(l2, h2), od, 0, 0, 0);
  od = __builtin_amdgcn_mfma_f32_32x32x16_bf16(pa3, PK(l3, h3), od, 0, 0, 0);
#undef PK
}
__device__ __forceinline__ void pv_d0(f32x16* o, int vb, bf16x8 pa0, bf16x8 pa1, bf16x8 pa2, bf16x8 pa3) {
  pv_one<0>(o[0], vb, pa0, pa1, pa2, pa3); pv_one<1>(o[1], vb, pa0, pa1, pa2, pa3); pv_one<2>(o[2], vb, pa0, pa1, pa2, pa3); pv_one<3>(o[3], vb, pa0, pa1, pa2, pa3);
}

struct Pf { bf16x8 v0, v1, k0; };
template <int ND0, int LDQ, int LDK, int LDO>
__device__ __forceinline__ void attn_unit(const bf16_t* __restrict__ Qb, const bf16_t* __restrict__ Kh, const bf16_t* __restrict__ Vh, bf16_t* __restrict__ Ob,
                                          int seq, int kofs, float C, float thr_raw, char* lds, int mode, const float* sg, float lam, float gscale,
                                          bf16x8& pfv0, bf16x8& pfv1, bf16x8& pfk0, int have_pf, const bf16_t* qkv, int nbh, int nkofs) {
  const int tid = tid_l(), wid = tid >> 6, lane = tid & 63, r32 = lane & 31, hi = lane >> 5;
  char* V_lds = lds; char* K_lds = lds + 2 * SHM_V;
  float* ws = (float*)(lds + 2 * SHM_V + 2 * SHM_K) + wid * 64; float* li_l = ws; float* al_l = ws + 32;
  constexpr bool PRE = true;
  float m_reg = PRE ? 0.f : -1e30f, l_reg = 0; f32x16 o[4] = {}; bf16x8 qr[ND0];
  const bf16_t* Qw = Qb + (long)(wid * QBLK + r32) * LDQ + hi * 8;
#pragma unroll
  for (int d0 = 0; d0 < ND0; ++d0) qr[d0] = *reinterpret_cast<const bf16x8*>(Qw + d0 * 16);
  const int sr = tid >> 4, sc = (tid & 15) * 8, vst0 = v_st(sr, sc), vst1 = v_st(32 + sr, sc);
  const int vb0 = (int)(uintptr_t)V_lds + v_rd_base(lane);
  bf16x8 vs0a, vs1a, ks0a, ks1a = {}, vs0b, vs1b, ks0b, ks1b = {};
  const int kr = tid >> 3, kcb = kofs + (tid & 7) * 16;
#define KLOAD(dst0, dst1, k0) do { if constexpr (ND0 == 4) { dst0 = *reinterpret_cast<const bf16x8*>(&Kh[(long)((k0) + kr) * LDK + (kcb >> 1)]); } \
    else { dst0 = *reinterpret_cast<const bf16x8*>(&Kh[(long)((k0) + sr) * LDK + sc]); dst1 = *reinterpret_cast<const bf16x8*>(&Kh[(long)((k0) + 32 + sr) * LDK + sc]); } } while (0)
#define KWRITE(b, src0, src1) do { if constexpr (ND0 == 4) { *(bf16x8*)(K_lds + (b) * SHM_K + KSWZ(kr, kcb)) = src0; } \
    else { int kc = sc * 2; *(bf16x8*)(K_lds + (b) * SHM_K + KSWZ(sr, kc)) = src0; *(bf16x8*)(K_lds + (b) * SHM_K + KSWZ(32 + sr, kc)) = src1; } } while (0)
#define SLOAD_A(k0) do { vs0a = *reinterpret_cast<const bf16x8*>(&Vh[(long)((k0) + sr) * LDK + sc]); vs1a = *reinterpret_cast<const bf16x8*>(&Vh[(long)((k0) + 32 + sr) * LDK + sc]); KLOAD(ks0a, ks1a, k0); } while (0)
#define SLOAD_B(k0) do { vs0b = *reinterpret_cast<const bf16x8*>(&Vh[(long)((k0) + sr) * LDK + sc]); vs1b = *reinterpret_cast<const bf16x8*>(&Vh[(long)((k0) + 32 + sr) * LDK + sc]); KLOAD(ks0b, ks1b, k0); } while (0)
#define SWRITE_A(b) do { *(bf16x8*)(V_lds + (b) * SHM_V + vst0) = vs0a; *(bf16x8*)(V_lds + (b) * SHM_V + vst1) = vs1a; KWRITE(b, ks0a, ks1a); } while (0)
#define SWRITE_B(b) do { *(bf16x8*)(V_lds + (b) * SHM_V + vst0) = vs0b; *(bf16x8*)(V_lds + (b) * SHM_V + vst1) = vs1b; KWRITE(b, ks0b, ks1b); } while (0)
#define VWRITE_A(b) do { *(bf16x8*)(V_lds + (b) * SHM_V + vst0) = vs0a; *(bf16x8*)(V_lds + (b) * SHM_V + vst1) = vs1a; } while (0)
#define VWRITE_B(b) do { *(bf16x8*)(V_lds + (b) * SHM_V + vst0) = vs0b; *(bf16x8*)(V_lds + (b) * SHM_V + vst1) = vs1b; } while (0)
#define SWAIT() do { if constexpr (ND0 == 4) asm volatile("s_waitcnt vmcnt(3)" ::: "memory"); else asm volatile("s_waitcnt vmcnt(4)" ::: "memory"); } while (0)
#define PSM(P0, P1, MN, AL) do { if constexpr (PRE) partialSM_pre(P0, P1, m_reg, AL, 11.541560327111707f); else partialSM(P0, P1, m_reg, MN, AL, C, thr_raw); } while (0)
#define RESC(a) do { if (__any((a) < 1.f)) { if (hi == 0) al_l[r32] = (a); asm volatile("s_waitcnt lgkmcnt(0)" ::: "memory"); \
    _Pragma("unroll") for (int d = 0; d < 4; ++d) _Pragma("unroll") for (int r = 0; r < 16; ++r) o[d][r] *= al_l[crow(r, hi)]; } } while (0)
  f32x16 pA0, pA1, pB0, pB1; float mnA, mnB, alA, alB; bf16x8 pa0, pa1, pa2, pa3; const int NT = seq / KVBLK;
  const char* Kq0 = K_lds + kofs; const char* Kq1 = K_lds + SHM_K + kofs;
  if (ND0 == 4 && have_pf) { vs0a = pfv0; vs1a = pfv1; ks0a = pfk0; } else { SLOAD_A(0); }
  asm volatile("s_waitcnt vmcnt(0)" ::: "memory"); SWRITE_A(0); __syncthreads();
  qkt<ND0>(pA0, pA1, Kq0, qr, r32, hi); PSM(pA0, pA1, mnA, alA);
  SLOAD_B(KVBLK); if (2 < NT) SLOAD_A(2 * KVBLK);
  SWAIT(); SWRITE_B(1); __syncthreads();
  for (int j = 1; j + 1 < NT; j += 2) {
    SBAR(); qkt<ND0>(pB0, pB1, Kq1, qr, r32, hi);
    finishSM(pA0, pA1, alA, l_reg, pa0, pa1, pa2, pa3); SBAR();
    SLOAD_B((j + 2) * KVBLK); SBAR();
    pv_d0(o, vb0, pa0, pa1, pa2, pa3); KWRITE(0, ks0a, ks1a); PSM(pB0, pB1, mnB, alB);
    __syncthreads(); SWAIT(); VWRITE_A(0);
    RESC(alB); __syncthreads();
    SBAR(); qkt<ND0>(pA0, pA1, Kq0, qr, r32, hi);
    finishSM(pB0, pB1, alB, l_reg, pa0, pa1, pa2, pa3); SBAR();
    if (j + 3 < NT) SLOAD_A((j + 3) * KVBLK); SBAR();
    pv_d0(o, vb0 + (int)SHM_V, pa0, pa1, pa2, pa3); KWRITE(1, ks0b, ks1b); PSM(pA0, pA1, mnA, alA);
    __syncthreads(); SWAIT(); VWRITE_B(1);
    RESC(alA); __syncthreads();
  }
  SBAR(); qkt<ND0>(pB0, pB1, Kq1, qr, r32, hi);
  finishSM(pA0, pA1, alA, l_reg, pa0, pa1, pa2, pa3); SBAR();
  pv_d0(o, vb0, pa0, pa1, pa2, pa3); PSM(pB0, pB1, mnB, alB);
  __syncthreads(); RESC(alB);
  finishSM(pB0, pB1, alB, l_reg, pa0, pa1, pa2, pa3); SBAR();
  pv_d0(o, vb0 + (int)SHM_V, pa0, pa1, pa2, pa3);
  if constexpr (ND0 == 4) { if (nbh >= 0) {
      const bf16_t* nK = qkv + (size_t)(nbh >> 3) * RPB * LDK + 1024 + (nbh & 7) * 128; const bf16_t* nV = nK + 1024;
      pfv0 = *reinterpret_cast<const bf16x8*>(&nV[(long)sr * LDK + sc]); pfv1 = *reinterpret_cast<const bf16x8*>(&nV[(long)(32 + sr) * LDK + sc]);
      pfk0 = *reinterpret_cast<const bf16x8*>(&nK[(long)kr * LDK + ((nkofs + (tid & 7) * 16) >> 1)]); }
    else { pfv0 = bf16x8{}; pfv1 = bf16x8{}; pfk0 = bf16x8{}; } }
  if (hi == 0) li_l[r32] = l_reg; asm volatile("s_waitcnt lgkmcnt(0)" ::: "memory");
  float rli[16];
#pragma unroll
  for (int r = 0; r < 16; ++r) rli[r] = __builtin_amdgcn_rcpf(li_l[crow(r, hi)]);
  __syncthreads();
  bf16_t* stg = (bf16_t*)(lds + (mode == 1 ? 69632 : 0) + wid * 8192);
#pragma unroll
  for (int r = 0; r < 16; ++r) { const int orow = crow(r, hi);
#pragma unroll
    for (int d0 = 0; d0 < 4; ++d0) stg[orow * 128 + d0 * 32 + r32] = (bf16_t)f2bf(o[d0][r] * rli[r]); }
  asm volatile("s_waitcnt lgkmcnt(0)" ::: "memory");
  bf16_t* Ow = Ob + (long)(wid * QBLK) * LDO;
  if (mode == 0) {
#pragma unroll
    for (int i = 0; i < 8; ++i) { const int row = i * 4 + (lane >> 4), ch = lane & 15; const u32x4 v = *(const u32x4*)(stg + row * 128 + ch * 8); *(u32x4*)(Ow + (long)row * LDO + ch * 8) = v; }
  } else if (mode == 2) {
    const bf16_t* st1 = (const bf16_t*)(lds + 69632 + wid * 8192); const int ch = lane & 15;
    const f32x4 g0 = *(const f32x4*)(sg + ch * 8) * gscale, g1 = *(const f32x4*)(sg + ch * 8 + 4) * gscale;
#pragma unroll
    for (int i = 0; i < 8; ++i) { const int row = i * 4 + (lane >> 4); const u32x4 w2 = *(const u32x4*)(stg + row * 128 + ch * 8), w1 = *(const u32x4*)(st1 + row * 128 + ch * 8);
      float d[8] = {bflo(w1.x) - lam * bflo(w2.x), bfhi(w1.x) - lam * bfhi(w2.x), bflo(w1.y) - lam * bflo(w2.y), bfhi(w1.y) - lam * bfhi(w2.y),
                    bflo(w1.z) - lam * bflo(w2.z), bfhi(w1.z) - lam * bfhi(w2.z), bflo(w1.w) - lam * bflo(w2.w), bfhi(w1.w) - lam * bfhi(w2.w)};
      float ss = 0.f;
#pragma unroll
      for (int e = 0; e < 8; ++e) ss += d[e] * d[e];
      const float rstd = __builtin_amdgcn_rsqf(sum16(ss) * (1.0f / 128.0f) + EPS);
      u32x4 ov; ov.x = cvtpk(d[0] * rstd * g0.x, d[1] * rstd * g0.y); ov.y = cvtpk(d[2] * rstd * g0.z, d[3] * rstd * g0.w);
      ov.z = cvtpk(d[4] * rstd * g1.x, d[5] * rstd * g1.y); ov.w = cvtpk(d[6] * rstd * g1.z, d[7] * rstd * g1.w);
      *(u32x4*)(Ow + (long)row * LDO + ch * 8) = ov; }
  }
  __syncthreads();
#undef SLOAD_A
#undef VWRITE_A
#undef VWRITE_B
#undef PSM
#undef KLOAD
#undef KWRITE
#undef SLOAD_B
#undef SWRITE_A
#undef SWRITE_B
#undef SWAIT
#undef RESC
}
#undef SBAR
}


#define XB_TMO      128
#define XB_XCNT(j)  (256  + 64 * (j))
#define XB_XSUB(j)  (1280 + 64 * (j))
#define XB_XGEN(j)  (2304 + 64 * (j))
#define XB_TOP      3328
#define XB_TOPGEN   3392
#define XCD_BAR_WORDS 3456
#define XB_SPIN_CAP (1u << 18)
__device__ __forceinline__ unsigned xb_ld(unsigned* p)              { return __hip_atomic_load(p, __ATOMIC_RELAXED, __HIP_MEMORY_SCOPE_AGENT); }
__device__ __forceinline__ unsigned xb_add(unsigned* p, unsigned v) { return __hip_atomic_fetch_add(p, v, __ATOMIC_RELAXED, __HIP_MEMORY_SCOPE_AGENT); }
__device__ __forceinline__ unsigned xb_xcc_id() { return (unsigned)__builtin_amdgcn_s_getreg((3 << 11) | 20) & 0xFu; }
#define XB_SPIN(cond, bar) do { unsigned _sp = 0; while (cond) { __builtin_amdgcn_s_sleep(1); \
    if ((++_sp & 255u) == 0u) { if (xb_ld(&(bar)[XB_TMO])) break; if (_sp > XB_SPIN_CAP) { atomicAdd(&(bar)[XB_TMO], 1u); break; } } } } while (0)
__device__ __forceinline__ void xcd_barrier_complete(unsigned* bar, unsigned x, unsigned& nloc, unsigned& nx) {
    const unsigned G = gridDim.x * gridDim.y * gridDim.z;
    unsigned sum, cnt, mine, sp = 0u;
    for (;;) {
        sum = 0u; cnt = 0u; mine = 0u;
#pragma unroll
        for (unsigned j = 0; j < 16; ++j) { const unsigned c = xb_ld(&bar[XB_XCNT(j)]); sum += c; cnt += (c > 0u) ? 1u : 0u; mine = (j == x) ? c : mine; }
        if (sum == G) break;
        __builtin_amdgcn_s_sleep(1);
        if ((++sp & 255u) == 0u) { if (xb_ld(&bar[XB_TMO])) break; if (sp > XB_SPIN_CAP) { atomicAdd(&bar[XB_TMO], 1u); break; } }
    }
    nloc = mine > 0u ? mine : 1u; nx = cnt > 0u ? cnt : 1u;
}
__device__ __forceinline__ void xcd_barrier(unsigned* bar, volatile LAS unsigned* st) {
    asm volatile("s_waitcnt vmcnt(0)" ::: "memory");
    __syncthreads();
    if (threadIdx.x == 0) {
        const unsigned x = xb_xcc_id();
        __builtin_amdgcn_s_waitcnt(0);
        unsigned nloc = st[0], nx = st[1];
        if (nloc == 0u) { xcd_barrier_complete(bar, x, nloc, nx); st[0] = nloc; st[1] = nx; }
        const unsigned old = xb_add(&bar[XB_XSUB(x)], 1u);
        const unsigned gen = old / nloc;
        if (old + 1u == (gen + 1u) * nloc) {
            __builtin_amdgcn_fence(__ATOMIC_RELEASE, "agent");
            asm volatile("s_waitcnt vmcnt(0)" ::: "memory");
            const unsigned og = xb_add(&bar[XB_TOP], 1u);
            const unsigned tg = og / nx;
            if (og + 1u == (tg + 1u) * nx) xb_add(&bar[XB_TOPGEN], 1u);
            else XB_SPIN(xb_ld(&bar[XB_TOPGEN]) == tg, bar);
            __builtin_amdgcn_fence(__ATOMIC_ACQUIRE, "agent");
            xb_add(&bar[XB_XGEN(x)], 1u);
            asm volatile("s_waitcnt vmcnt(0)" ::: "memory");
        } else {
            XB_SPIN(xb_ld(&bar[XB_XGEN(x)]) == gen, bar);
            __builtin_amdgcn_fence(__ATOMIC_ACQUIRE, "agent");
            asm volatile("s_waitcnt vmcnt(0)" ::: "memory");
        }
    }
    __syncthreads();
}

struct Args { const float* in[21]; float* out; unsigned char* ws; int ph_lo, ph_hi; };

enum Kind { K_PRO = 0, K_NM_MIX, K_G_QKV, K_QKPOST, K_ATTN, K_COMBINE, K_G_OUT, K_NM_FFN, K_G_GU, K_G_DOWN, K_NM_T, K_G_POS, K_G_CH, K_FINAL };
constexpr int N_PHASES = 30;
__device__ __forceinline__ void decode_phase(int ph, int& layer, int& kind) {
    if (ph == 0) { layer = 0; kind = K_PRO; return; }
    if (ph == N_PHASES - 1) { layer = 3; kind = K_FINAL; return; }
    int p = ph - 1;
    if (p < 7) { layer = 0; kind = (p < 2) ? K_NM_MIX + p : (p == 2) ? K_ATTN : K_G_OUT + (p - 3); return; } p -= 7;
    if (p < 7) { layer = 1; kind = (p < 2) ? K_NM_MIX + p : (p == 2) ? K_ATTN : K_G_OUT + (p - 3); return; } p -= 7;
    if (p < 7) { layer = 2; kind = (p == 0) ? K_NM_T : (p == 1) ? K_G_POS : (p == 2) ? K_G_CH : K_G_OUT + (p - 3); return; } p -= 7;
    layer = 3; kind = (p < 2) ? K_NM_MIX + p : (p == 2) ? K_ATTN : K_G_OUT + (p - 3);
}

__device__ __forceinline__ void transpose_item(const float* W, int K, int N, bf16_t* WT, int k0, int n0, int drow0, LAS float* scr, int lane) {
    float tv[32];
#pragma unroll
    for (int i = 0; i < 32; ++i) tv[i] = W[(size_t)(k0 + 2 * i + (lane >> 5)) * N + n0 + (lane & 31)];
#pragma unroll
    for (int i = 0; i < 32; ++i) scr[(2 * i + (lane >> 5)) * 33 + (lane & 31)] = tv[i];
    asm volatile("s_waitcnt lgkmcnt(0)" ::: "memory");
    const int c = lane & 7;
#pragma unroll
    for (int j = 0; j < 4; ++j) { const int n = (lane >> 3) + 8 * j; const LAS float* s = scr + (8 * c) * 33 + n;
        u32x4 o; o.x = cvt_pk_bf16(s[0 * 33], s[1 * 33]); o.y = cvt_pk_bf16(s[2 * 33], s[3 * 33]); o.z = cvt_pk_bf16(s[4 * 33], s[5 * 33]); o.w = cvt_pk_bf16(s[6 * 33], s[7 * 33]);
        *(u32x4*)(WT + (size_t)(drow0 + n) * K + k0 + 8 * c) = o; }
    asm volatile("s_waitcnt lgkmcnt(0)" ::: "memory");
}
__device__ __forceinline__ void transpose_matrix(const float* W, int K, int N, bf16_t* WT, bool perm_gu, int& itbase, int gw, int NGW, LAS float* scr, int lane) {
    const int nblk = N / 32, nitems = (K / 64) * nblk;
    int first = (gw - itbase % NGW + NGW) % NGW;
    for (int it = first; it < nitems; it += NGW) {
        const int kb = it / nblk, nb = it - kb * nblk, n0 = nb * 32; int drow0 = n0;
        if (perm_gu) { drow0 = (n0 < DFF) ? (n0 / 128) * 256 + (n0 % 128) : ((n0 - DFF) / 128) * 256 + 128 + ((n0 - DFF) % 128); }
        transpose_item(W, K, N, WT, kb * 64, n0, drow0, scr, lane);
    }
    itbase += nitems;
}

__global__ void __launch_bounds__(512, 2) fwd_megakernel(Args args) {
    extern __shared__ __attribute__((aligned(16))) unsigned char lds_raw[];
    LAS unsigned char* lds = (LAS unsigned char*)lds_raw;
    cg::grid_group grid = cg::this_grid();
    typedef __attribute__((address_space(4))) const Args* KArgsPtr;
    volatile LAS unsigned* bar_st = (volatile LAS unsigned*)(lds + LDS_BYTES - 64);
    unsigned* bar_words = (unsigned*)(args.ws + WS_BAR);
    if (threadIdx.x < 2) bar_st[threadIdx.x] = 0u;
    __syncthreads();
    if (threadIdx.x == 0) (void)xb_add(&bar_words[XB_XCNT(xb_xcc_id())], 1u);

    for (int sl_ = args.ph_lo; sl_ < args.ph_hi; ++sl_) {
#ifdef PROBE_MASK
        const int ph = sl_ >> 1; { int l_, k_; decode_phase(ph, l_, k_); if ((sl_ & 1) && !((PROBE_MASK >> k_) & 1)) continue; }
#else
        const int ph = sl_;
#endif
        int G = gridDim.x, bx = blockIdx.x; asm volatile("" : "+s"(G), "+s"(bx));
        const int NGW = G * 8, NGT = G * 512;
        const int tid = tid_l(), lane = tid & 63, wave = __builtin_amdgcn_readfirstlane(tid >> 6);
        const int gw = bx * 8 + wave, gtid = bx * 512 + tid;
        KArgsPtr ka = (KArgsPtr)__builtin_amdgcn_kernarg_segment_ptr(); asm volatile("" : "+s"(ka));
#define AIN(i) (ka->in[i])
        unsigned char* ws = ka->ws;
        const float* x_in = AIN(0); const float* c_in = AIN(1); const float* ctx_in = AIN(2); const float* cctx_in = AIN(3);
        float* modv = (float*)(ws + WS_MODV); float* ropeA = (float*)(ws + WS_ROPEA); float* ropeB = (float*)(ws + WS_ROPEB);
        float* xc_ws = (float*)(ws + WS_XC); float* xl_ws = ka->out;
        bf16_t* R1 = (bf16_t*)(ws + WS_R1); bf16_t* R2 = (bf16_t*)(ws + WS_R2); bf16_t* R3 = (bf16_t*)(ws + WS_R3);
        int layer, kind; decode_phase(ph, layer, kind);

        const int mixer = layer % 3, mj = layer / 3;
        const float* xl_cur = (layer == 0 && kind <= K_G_OUT) ? x_in : xl_ws;
        const float* xc_cur = xc_ws;
        const bool last = (layer == 3);
        const bool fuse_ok = (G == 256);
        if (fuse_ok && (kind == K_FINAL || (kind == K_NM_FFN && last))) continue;
        const float* modl = modv + (size_t)layer * 9 * 6144;
        pg8::Gemm gd{}, gd2{}; pg8::Order gS{}, gS2{}; pg8::EpiStore eS{}; pg8::EpiResid eR{}; int gk = 0, gk2 = 0; float* part2 = nullptr;
        switch (kind) {
        case K_PRO: {
            LAS float* scr = (LAS float*)(lds + wave * 8704);
            int itbase = 0;
            for (int l = 0; l < 2; ++l) transpose_matrix(AIN(10) + (size_t)l * 1024 * 3072, 1024, 3072, (bf16_t*)(ws + WS_WQKVA) + (size_t)l * 3072 * 1024, false, itbase, gw, NGW, scr, lane);
            for (int l = 0; l < 2; ++l) transpose_matrix(AIN(13) + (size_t)l * 1024 * 1024, 1024, 1024, (bf16_t*)(ws + WS_WOA) + (size_t)l * 1024 * 1024, false, itbase, gw, NGW, scr, lane);
            transpose_matrix(AIN(14), 1024, 1536, (bf16_t*)(ws + WS_WQKVB), false, itbase, gw, NGW, scr, lane);
            transpose_matrix(AIN(17), 1024, 1024, (bf16_t*)(ws + WS_WOB), false, itbase, gw, NGW, scr, lane);
            transpose_matrix(AIN(18), 1024, 1024, (bf16_t*)(ws + WS_WOC), false, itbase, gw, NGW, scr, lane);
            for (int l = 0; l < 4; ++l) transpose_matrix(AIN(8) + (size_t)l * 1024 * 5632, 1024, 5632, (bf16_t*)(ws + WS_WGU) + (size_t)l * 5632 * 1024, true, itbase, gw, NGW, scr, lane);
            for (int l = 0; l < 4; ++l) transpose_matrix(AIN(9) + (size_t)l * 2816 * 1024, 2816, 1024, (bf16_t*)(ws + WS_WDN) + (size_t)l * 1024 * 2816, false, itbase, gw, NGW, scr, lane);
            LAS float* sl = (LAS float*)(lds + 69632);
            LAS float* part = (LAS float*)(lds + 69632 + 36864);
            for (int i = tid; i < 9 * 1024; i += 512) { const int mi = i >> 10, k = i & 1023; const float v = (mi < 8) ? c_in[mi * 1024 + k] : cctx_in[k]; sl[i] = silu_f(v); }
            __syncthreads();
            for (int it = bx; it < 4 * 96; it += G) {
                const int l = it / 96, n0 = (it % 96) * 64;
                const float* W = AIN(4) + (size_t)l * 1024 * 6144 + n0 + lane;
                float a[9];
#pragma unroll
                for (int mi = 0; mi < 9; ++mi) a[mi] = 0.f;
                for (int k0 = wave * 128; k0 < wave * 128 + 128; k0 += 16) { float wv[16];
#pragma unroll
                    for (int kk = 0; kk < 16; ++kk) wv[kk] = W[(size_t)(k0 + kk) * 6144];
#pragma unroll
                    for (int kk = 0; kk < 16; ++kk)
#pragma unroll
                        for (int mi = 0; mi < 9; ++mi) a[mi] += sl[mi * 1024 + k0 + kk] * wv[kk]; }
#pragma unroll
                for (int mi = 0; mi < 9; ++mi) part[(wave * 9 + mi) * 64 + lane] = a[mi];
                __syncthreads();
                for (int i = tid; i < 576; i += 512) { const int mi = i >> 6, n = i & 63; float s = 0.f;
#pragma unroll
                    for (int w = 0; w < 8; ++w) s += part[(w * 9 + mi) * 64 + n];
                    modv[((size_t)l * 9 + mi) * 6144 + n0 + n] = s + AIN(5)[l * 6144 + n0 + n]; }
                __syncthreads();
            }
            for (int i = gtid; i < NB * CTXL * DM / 4; i += NGT) ((f32x4*)xc_ws)[i] = ((const f32x4*)ctx_in)[i];
            for (int i = gtid; i < 64 * 16; i += NGT) { const int pos = i >> 4, f = i & 15; const float inv = __builtin_amdgcn_exp2f(-(float)f * (13.287712379549449f / 16.0f));
                float tr = (float)pos * inv * 0.15915494309189535f; tr -= floorf(tr); ropeA[2 * i] = __builtin_amdgcn_cosf(tr); ropeA[2 * i + 1] = __builtin_amdgcn_sinf(tr); }
            for (int i = gtid; i < 64 * 32; i += NGT) { const int pos = i >> 5, f = i & 31; const float inv = __builtin_amdgcn_exp2f(-(float)f * (13.287712379549449f / 32.0f));
                float tr = (float)pos * inv * 0.15915494309189535f; tr -= floorf(tr); ropeB[2 * i] = __builtin_amdgcn_cosf(tr); ropeB[2 * i + 1] = __builtin_amdgcn_sinf(tr); }
            bf16_t* csctx = (bf16_t*)(ws + WS_CSCTX); bf16_t* dc = (bf16_t*)(ws + WS_DC);
            for (int i = gtid; i < 256 * 256; i += NGT) { const int r = i >> 8, n = i & 255, half = (r >> 7) & 1; int k = r & 127; int hf = half; if (half && k == 0) { k = 128; hf = 0; }
                const float tr = (float)((k * n) & 255) * (1.0f / 256.0f); const float v = (hf ? __builtin_amdgcn_sinf(tr) : __builtin_amdgcn_cosf(tr)) * 0.0625f; csctx[i] = (bf16_t)f2bf(v); }
            for (int i = gtid; i < 256 * 512; i += NGT) { const int j = i >> 9, col = i & 511, cs = col >> 8, cch = col & 255;
                const float tr = (float)((cch * j) & 255) * (1.0f / 256.0f); const float v = (cs ? -__builtin_amdgcn_sinf(tr) : __builtin_amdgcn_cosf(tr)) * 0.0625f; dc[i] = (bf16_t)f2bf(v); }
        } break;
        case K_NM_MIX: case K_NM_FFN: {
            const float* ln = (kind == K_NM_MIX ? AIN(6) : AIN(7)) + layer * 1024; const int chunk = (kind == K_NM_MIX) ? 0 : 3;
            if (!(last && kind == K_NM_FFN)) {
                int pS = 0; const float* pP = nullptr; const float* pg = nullptr; const float* pb = nullptr;
                if (kind == K_NM_FFN) { pS = 4; pP = (const float*)R1; pg = modl + 8 * 6144 + 2 * 1024; pb = (mixer == 2) ? AIN(19) : nullptr; }
                else if (layer == 1 || layer == 3) { pS = 11; pP = (const float*)R2; pg = modv + (size_t)(layer - 1) * 9 * 6144 + 8 * 6144 + 5 * 1024; }
                const float* sh = modl + 8 * 6144 + chunk * 1024; const float* sc = sh + 1024;
                for (int cr = gw; cr < NB * CTXL; cr += NGW) {
                    f32x4* xr = (f32x4*)(xc_ws + (size_t)cr * DM); f32x4 v[4];
#pragma unroll
                    for (int j = 0; j < 4; ++j) v[j] = xr[lane + 64 * j];
                    if (pS) { f32x4 a4[4];
#pragma unroll
                        for (int j = 0; j < 4; ++j) a4[j] = pb ? ((const f32x4*)pb)[lane + 64 * j] : (f32x4){0.f, 0.f, 0.f, 0.f};
                        for (int s = 0; s < pS; ++s) { const f32x4* pr = (const f32x4*)(pP + ((size_t)s * (NB * CTXL) + cr) * DM);
#pragma unroll
                            for (int j = 0; j < 4; ++j) a4[j] += pr[lane + 64 * j]; }
#pragma unroll
                        for (int j = 0; j < 4; ++j) { v[j] += ((const f32x4*)pg)[lane + 64 * j] * a4[j]; xr[lane + 64 * j] = v[j]; } }
                    float ss = 0.f;
#pragma unroll
                    for (int j = 0; j < 4; ++j) ss += (v[j].x * v[j].x + v[j].y * v[j].y) + (v[j].z * v[j].z + v[j].w * v[j].w);
                    const float rstd = __builtin_amdgcn_rsqf(wave_sum(ss) * (1.0f / DM) + EPS);
                    u32x2* o8 = (u32x2*)(R3 + ((size_t)(cr >> 8) * RPB + (cr & 255)) * DM) + lane;
#pragma unroll
                    for (int j = 0; j < 4; ++j) { const f32x4 y = v[j] * rstd * (((const f32x4*)ln)[lane + 64 * j] * (((const f32x4*)sc)[lane + 64 * j] + 1.0f)) + ((const f32x4*)sh)[lane + 64 * j];
                        u32x2 w; w.x = cvt_pk_bf16(y.x, y.y); w.y = cvt_pk_bf16(y.z, y.w); o8[64 * j] = w; }
                }
            }
            const bool nm_fused = fuse_ok && (kind == K_NM_FFN || layer == 1 || layer == 3);
            const int NLAT = nm_fused ? 0 : NB * SEQ, rpw = (((NB * SEQ + NGW - 1) / NGW) + 3) & ~3, r0 = gw * rpw, r1 = (r0 + rpw < NLAT) ? r0 + rpw : NLAT;
            f32x4 v[4][4] = {}, vn[4][4] = {}, Am[4] = {}, Bm[4] = {}; int cur_mi = -1;
#pragma unroll
            for (int q = 0; q < 4; ++q) if (r0 + q < r1) { const float* xr = xl_cur + (size_t)(r0 + q) * DM;
#pragma unroll
                for (int j = 0; j < 4; ++j) v[q][j] = ((const f32x4*)xr)[lane + 64 * j]; }
            for (int row = r0; row < r1; row += 4) {
#pragma unroll
                for (int q = 0; q < 4; ++q) if (row + 4 + q < r1) { const float* xr = xl_cur + (size_t)(row + 4 + q) * DM;
#pragma unroll
                    for (int j = 0; j < 4; ++j) vn[q][j] = ((const f32x4*)xr)[lane + 64 * j]; }
                const int mi = row >> 12;
                if (mi != cur_mi) { cur_mi = mi; const float* sh = modl + mi * 6144 + chunk * 1024; const float* sc = sh + 1024;
#pragma unroll
                    for (int j = 0; j < 4; ++j) { Am[j] = ((const f32x4*)ln)[lane + 64 * j] * (((const f32x4*)sc)[lane + 64 * j] + 1.0f); Bm[j] = ((const f32x4*)sh)[lane + 64 * j]; } }
                float rstd[4];
#pragma unroll
                for (int q = 0; q < 4; ++q) { float ss = 0.f;
#pragma unroll
                    for (int j = 0; j < 4; ++j) ss += (v[q][j].x * v[q][j].x + v[q][j].y * v[q][j].y) + (v[q][j].z * v[q][j].z + v[q][j].w * v[q][j].w);
                    rstd[q] = __builtin_amdgcn_rsqf(wave_sum(ss) * (1.0f / DM) + EPS); }
#pragma unroll
                for (int q = 0; q < 4; ++q) if (row + q < r1) { u32x2* o8 = (u32x2*)(R3 + ((size_t)mi * RPB + CTXL + ((row + q) & 4095)) * DM) + lane;
#pragma unroll
                    for (int j = 0; j < 4; ++j) { const f32x4 y = v[q][j] * rstd[q] * Am[j] + Bm[j]; u32x2 w; w.x = cvt_pk_bf16(y.x, y.y); w.y = cvt_pk_bf16(y.z, y.w); o8[64 * j] = w; } }
#pragma unroll
                for (int q = 0; q < 4; ++q)
#pragma unroll
                    for (int j = 0; j < 4; ++j) v[q][j] = vn[q][j];
            }
        } break;
        case K_NM_T: {
            const float* ln = AIN(6) + layer * 1024;
            LAS bf16_t* tile = (LAS bf16_t*)lds;
            bf16_t* HTl = R3; bf16_t* HTc = (bf16_t*)((unsigned char*)R3 + R3_HTC_OFF);
            for (int it = bx; it < MROWS / 64; it += G) {
                const int row0 = it * 64, b = row0 / RPB, t0 = row0 - b * RPB; const bool isc = t0 < CTXL;
                const float* sh = modl + (isc ? 8 : b) * 6144; const float* sc = sh + 1024;
                float Ac[16], Bc[16], v[16], vn[16] = {};
#pragma unroll
                for (int j = 0; j < 16; ++j) { const int col = lane + 64 * j; Ac[j] = ln[col] * (sc[col] + 1.0f); Bc[j] = sh[col]; }
                { const int t = t0 + wave * 8; const float* xr = isc ? xc_cur + (size_t)(b * CTXL + t) * DM : xl_cur + (size_t)(b * SEQ + t - CTXL) * DM;
#pragma unroll
                  for (int j = 0; j < 16; ++j) v[j] = xr[lane + 64 * j]; }
                const float* pgT = modv + (size_t)(layer - 1) * 9 * 6144 + 8 * 6144 + 5 * 1024;
                for (int i = 0; i < 8; ++i) { const int rr = wave * 8 + i;
                    if (isc) { const int cr = b * CTXL + t0 + rr; const float* p0 = (const float*)R2 + (size_t)cr * DM; const float* p1 = p0 + (size_t)NB * CTXL * DM; float* xw = xc_ws + (size_t)cr * DM;
#pragma unroll
                        for (int j = 0; j < 16; ++j) { const int col = lane + 64 * j; v[j] += pgT[col] * (p0[col] + p1[col]); xw[col] = v[j]; } }
                    if (i + 1 < 8) { const int t = t0 + rr + 1; const float* xr = isc ? xc_cur + (size_t)(b * CTXL + t) * DM : xl_cur + (size_t)(b * SEQ + t - CTXL) * DM;
#pragma unroll
                        for (int j = 0; j < 16; ++j) vn[j] = xr[lane + 64 * j]; }
                    float ss = 0.f;
#pragma unroll
                    for (int j = 0; j < 16; ++j) ss += v[j] * v[j];
                    const float rstd = __builtin_amdgcn_rsqf(wave_sum(ss) * (1.0f / DM) + EPS);
#pragma unroll
                    for (int j = 0; j < 16; ++j) { const float y = v[j] * rstd * Ac[j] + Bc[j]; tile[(lane + 64 * j) * 66 + rr] = (bf16_t)f2bf(y); }
#pragma unroll
                    for (int j = 0; j < 16; ++j) v[j] = vn[j]; }
                __syncthreads();
                for (int idx = tid; idx < 1024 * 32; idx += 512) { const int cch = idx >> 5, tp = idx & 31; const unsigned w = *(const LAS unsigned*)(tile + cch * 66 + 2 * tp);
                    bf16_t* dst = isc ? HTc + ((size_t)(b * 1024 + cch) * CTXL + t0 + 2 * tp) : HTl + ((size_t)(b * 1024 + cch) * SEQ + (t0 - CTXL) + 2 * tp);
                    *(unsigned*)dst = w; }
                __syncthreads();
            }
            bf16_t* CS = (bf16_t*)((unsigned char*)R2 + R2_CS_OFF);
            for (int idx = gtid; idx < 4096 * 512; idx += NGT) { const int r = idx >> 9, n0 = (idx & 511) * 8; int half = (r >> 7) & 1, k = (r >> 8) * 128 + (r & 127); if (half && k == 0) { k = 2048; half = 0; }
                float vv[8];
#pragma unroll
                for (int e = 0; e < 8; ++e) { const float tr = (float)((k * (n0 + e)) & 4095) * (1.0f / 4096.0f); vv[e] = (half ? __builtin_amdgcn_sinf(tr) : __builtin_amdgcn_cosf(tr)) * 0.015625f; }
                u32x4 w; w.x = cvt_pk_bf16(vv[0], vv[1]); w.y = cvt_pk_bf16(vv[2], vv[3]); w.z = cvt_pk_bf16(vv[4], vv[5]); w.w = cvt_pk_bf16(vv[6], vv[7]);
                *(u32x4*)(CS + (size_t)r * 4096 + n0) = w; }
        } break;
        case K_G_QKV: {
            if (mixer == 0) { gd = pg8::Gemm{R3, (const bf16_t*)(ws + WS_WQKVA) + (size_t)mj * 3072 * 1024, 1024, 1024, 1024, 0, 0}; gS.init(MROWS / 256, 12, 1, G, bx); eS = pg8::EpiStore{R1, 3072, 0, ropeA, 8}; }
            else { gd = pg8::Gemm{R3, (const bf16_t*)(ws + WS_WQKVB), 1024, 1024, 1024, 0, 0}; gS.init(MROWS / 256, 6, 1, G, bx); }
            gk = (mixer == 0) ? 1 : 5;
        } break;
        case K_G_CH: {
            gS.init(MROWS / 256, 1, 4, G, bx);
            gd = pg8::Gemm{R1, (const bf16_t*)(ws + WS_DC), 2048, 512, 512, 512 * 2, 0};
            eS = pg8::EpiStore{R2, 1024, 256, nullptr, 0}; gk = 1;
        } break;
        case K_G_POS: gk = 4; break;
        case K_G_OUT: {
            const bf16_t* A = (mixer == 0) ? R3 : R2;
            const bf16_t* W = (mixer == 0) ? (const bf16_t*)(ws + WS_WOA) + (size_t)mj * 1024 * 1024 : (mixer == 1) ? (const bf16_t*)(ws + WS_WOB) : (const bf16_t*)(ws + WS_WOC);
            gS.init(128, 4, 1, G, bx, 2);
            gd = pg8::Gemm{A, W, 1024, 1024, 1024, 0, 0};
            eR = pg8::EpiResid{xl_cur, xc_cur, xl_ws, xc_ws, modl + 2 * 1024, (mixer == 2) ? AIN(19) : nullptr, nullptr,
                               fuse_ok ? 1 : 0, R3, AIN(7) + layer * 1024, modl + 3 * 1024, (float*)(ws + WS_XBUF), (unsigned*)(ws + WS_CNT) + (size_t)(layer * 2) * 128 * 64, lds + pg8::STAGE_BYTES}; gk = 2;
            if (!last) { gS2.init(8, 4, 4, G, bx, 1); gd2 = pg8::Gemm{A, W, 1024, 1024, 256, 512, 512}; gk2 = 1; part2 = (float*)R1; }
        } break;
        case K_G_GU: {
            if (last) gS.init(128, 22, 1, G, bx, 2); else gS.init(MROWS / 256, 22, 1, G, bx);
            gd = pg8::Gemm{R3, (const bf16_t*)(ws + WS_WGU) + (size_t)layer * 5632 * 1024, 1024, 1024, 1024, 0, 0}; gk = 3;
        } break;
        case K_G_DOWN: {
            const bf16_t* W = (const bf16_t*)(ws + WS_WDN) + (size_t)layer * 1024 * 2816;
            gS.init(128, 4, 1, G, bx, 2);
            gd = pg8::Gemm{R1, W, 2816, 2816, 2816, 0, 0};
            eR = pg8::EpiResid{xl_ws, xc_ws, xl_ws, xc_ws, modl + 5 * 1024, nullptr, nullptr,
                               (!fuse_ok || layer == 1) ? 0 : (last ? 2 : 1), R3, last ? AIN(20) : AIN(6) + (layer + 1) * 1024, modv + (size_t)(layer + 1) * 9 * 6144, (float*)(ws + WS_XBUF),
                               (unsigned*)(ws + WS_CNT) + (size_t)(layer * 2 + 1) * 128 * 64, lds + pg8::STAGE_BYTES}; gk = 2;
            if (layer == 0 || layer == 2) { gS2.init(8, 4, 11, G, bx, 1); gd2 = pg8::Gemm{R1, W, 2816, 2816, 256, 512, 512}; gk2 = 1; part2 = (float*)R2; }
            if (layer == 1) { gS2.init(8, 4, 2, G, bx, 1); gd2 = pg8::Gemm{R1, W, 2816, 2816, 1408, 2816, 2816}; gk2 = 1; part2 = (float*)R2; }
        } break;
        case K_QKPOST: {
            const float* qn = AIN(15); const float* kn = AIN(16);
            const int rpw = (MROWS + NGW - 1) / NGW, r0 = gw * rpw, r1 = (r0 + rpw < MROWS) ? r0 + rpw : MROWS;
            const int wi = (lane & 15) * 8, p0 = (lane & 15) * 4, f0 = p0 & 31;
            const float qsc = 0.088388347648318440f * 1.4426950408889634f;
            const f32x4 gq0 = *(const f32x4*)(qn + wi) * qsc, gq1 = *(const f32x4*)(qn + wi + 4) * qsc, gk0 = *(const f32x4*)(kn + wi), gk1 = *(const f32x4*)(kn + wi + 4);
            for (int row = r0; row < r1; row += 4) {
                u32x4 w[4][3]; f32x4 c0[4], c1[4];
#pragma unroll
                for (int q = 0; q < 4; ++q) { const int rq = (row + q < r1) ? row + q : r1 - 1;
                    const int b = rq / RPB, t = rq - b * RPB; const bool isc = t < CTXL; const int tl = isc ? 0 : t - CTXL, rp = tl >> 6, cp = tl & 63, pos = (p0 < 32) ? rp : cp;
#pragma unroll
                    for (int j = 0; j < 3; ++j) w[q][j] = *(const u32x4*)(R1 + (size_t)rq * 1536 + (j * 64 + lane) * 8);
                    c0[q] = *(const f32x4*)(ropeB + (pos * 32 + f0) * 2); c1[q] = *(const f32x4*)(ropeB + (pos * 32 + f0) * 2 + 4);
                    if (isc) { c0[q] = (f32x4){1.f, 0.f, 1.f, 0.f}; c1[q] = c0[q]; } }
#pragma unroll
                for (int q = 0; q < 4; ++q) if (row + q < r1) { const f32x4 cs0 = c0[q], cs1 = c1[q];
#pragma unroll
                    for (int j = 0; j < 3; ++j) { const int head = (j * 64 + lane) >> 4; const u32x4 ww = w[q][j];
                        float xv[8] = {bflo(ww.x), bfhi(ww.x), bflo(ww.y), bfhi(ww.y), bflo(ww.z), bfhi(ww.z), bflo(ww.w), bfhi(ww.w)};
                        float ss = 0.f;
#pragma unroll
                        for (int e = 0; e < 8; ++e) ss += xv[e] * xv[e];
                        const float rstd = __builtin_amdgcn_rsqf(sum16(ss) * (1.0f / 128.0f) + EPS);
                        const f32x4 g0 = (head < 8) ? gq0 : gk0, g1 = (head < 8) ? gq1 : gk1;
                        const float a0 = xv[0] * rstd * g0.x, a1 = xv[1] * rstd * g0.y, b0 = xv[2] * rstd * g0.z, b1 = xv[3] * rstd * g0.w;
                        const float e0 = xv[4] * rstd * g1.x, e1 = xv[5] * rstd * g1.y, d0 = xv[6] * rstd * g1.z, d1 = xv[7] * rstd * g1.w;
                        u32x4 o; o.x = cvt_pk_bf16(a0 * cs0.x - a1 * cs0.y, a0 * cs0.y + a1 * cs0.x); o.y = cvt_pk_bf16(b0 * cs0.z - b1 * cs0.w, b0 * cs0.w + b1 * cs0.z);
                        o.z = cvt_pk_bf16(e0 * cs1.x - e1 * cs1.y, e0 * cs1.y + e1 * cs1.x); o.w = cvt_pk_bf16(d0 * cs1.z - d1 * cs1.w, d0 * cs1.w + d1 * cs1.z);
                        if (head < 10) *(u32x4*)(R1 + (size_t)(row + q) * 1536 + (j * 64 + lane) * 8) = o; } }
            }
        } break;
        case K_ATTN: {
            char* albs = (char*)lds_raw;
            const bool need_ctx = (layer != 3);
            const int gx = (G % 8 == 0) ? G / 8 : G, xcd = (G % 8 == 0) ? bx % 8 : 0, vl = (G % 8 == 0) ? bx / 8 : bx, nxc = (G % 8 == 0) ? 8 : 1;
            if (mixer == 0) {
                const float C = 0.125f * 1.4426950408889634f, thr = 8.f / 0.125f;
                const float* lv = AIN(11) + mj * 256; const float* sg = AIN(12) + mj * 128;
                const float linit = (layer == 0) ? LAMINIT0 : LAMINIT3;
                const float sa = wave_sum(lv[lane] * lv[64 + lane]), sb = wave_sum(lv[128 + lane] * lv[192 + lane]);
                const float lam = __expf(sa) - __expf(sb) + linit;
                const int per_x = 1024 / nxc, nlat = (per_x - vl + gx - 1) / gx, nctx = need_ctx ? (64 - bx + G - 1) / G : 0;
                bf16x8 pfv0 = {}, pfv1 = {}, pfk0 = {}; const int nunits = 2 * (nlat + (nctx > 0 ? nctx : 0));
                for (int i2 = 0; i2 < nunits; ++i2) {
                    const int i = i2 >> 1, comp = i2 & 1;
                    int b, h, seq; size_t qrow;
                    if (i < nlat) { const int U = xcd * per_x + vl + i * gx, bh = U >> 4; b = bh >> 3; h = bh & 7; qrow = (size_t)b * RPB + CTXL + (U & 15) * 256; seq = RPB; }
                    else { const int bh = bx + (i - nlat) * G; b = bh >> 3; h = bh & 7; qrow = (size_t)b * RPB; seq = CTXL; }
                    const size_t krow = (size_t)b * RPB;
                    int nbh = -1;
                    if (comp == 0) nbh = b * 8 + h;
                    else if (i2 + 1 < nunits) { const int i1 = i + 1; nbh = (i1 < nlat) ? ((xcd * per_x + vl + i1 * gx) >> 4) : bx + (i1 - nlat) * G; }
#ifndef NO_ATTN4
                    att::attn_unit<4, 3072, 3072, 1024>(R1 + qrow * 3072 + h * 128 + comp * 64, R1 + krow * 3072 + 1024 + h * 128, R1 + krow * 3072 + 2048 + h * 128,
                                                        R3 + qrow * 1024 + h * 128, seq, comp * 128, C, thr, albs, 1 + comp, sg, lam, 1.0f - linit, pfv0, pfv1, pfk0, i2 > 0, R1, nbh, comp ? 0 : 128);
#endif
                }
            } else {
                const float sc_ = 0.088388347648318440f; const float C = sc_ * 1.4426950408889634f, thr = 8.f / sc_;
                const int per_x = 1024 / nxc, nlat = (per_x - vl + gx - 1) / gx, nctx = need_ctx ? (64 - bx + G - 1) / G : 0;
                bf16x8 pg0 = {}, pg1 = {}, pg2 = {};
                for (int i = 0; i < nlat + (nctx > 0 ? nctx : 0); ++i) {
                    int b, qh, kvh, seq; size_t qrow;
                    if (i < nlat) { const int U = xcd * per_x + vl + i * gx, combo = U >> 6, k = U & 63; b = combo >> 1; kvh = combo & 1; qh = kvh * 4 + (k >> 4); qrow = (size_t)b * RPB + CTXL + (k & 15) * 256; seq = RPB; }
                    else { const int U = bx + (i - nlat) * G; b = U >> 3; qh = U & 7; kvh = qh >> 2; qrow = (size_t)b * RPB; seq = CTXL; }
                    const size_t krow = (size_t)b * RPB;
#ifndef NO_ATTN8
                    att::attn_unit<8, 1536, 1536, 1024>(R1 + qrow * 1536 + qh * 128, R1 + krow * 1536 + 1024 + kvh * 128, R1 + krow * 1536 + 1280 + kvh * 128,
                                                        R2 + qrow * 1024 + qh * 128, seq, 0, C, thr, albs, 0, nullptr, 0.f, 0.f, pg0, pg1, pg2, 0, nullptr, -1, 0);
#endif
                }
            }
        } break;
        case K_COMBINE: {
            const float* lv = AIN(11) + mj * 256; const float* sg = AIN(12) + mj * 128;
            const float linit = (layer == 0) ? LAMINIT0 : LAMINIT3;
            const float sa = wave_sum(lv[lane] * lv[64 + lane]), sb = wave_sum(lv[128 + lane] * lv[192 + lane]);
            const float lam = __expf(sa) - __expf(sb) + linit;
            const int wi = (lane & 15) * 8; const f32x4 g0 = *(const f32x4*)(sg + wi) * (1.0f - linit), g1 = *(const f32x4*)(sg + wi + 4) * (1.0f - linit);
            const int rpw = (MROWS + NGW - 1) / NGW, r0 = gw * rpw, r1 = (r0 + rpw < MROWS) ? r0 + rpw : MROWS;
            u32x4 q1[2] = {}, q2[2] = {}, n1[2] = {}, n2[2] = {};
            if (r0 < r1) {
#pragma unroll
                for (int j = 0; j < 2; ++j) { const int head = (j * 64 + lane) >> 4; q1[j] = *(const u32x4*)(R2 + (size_t)r0 * 2048 + head * 256 + wi); q2[j] = *(const u32x4*)(R2 + (size_t)r0 * 2048 + head * 256 + 128 + wi); } }
            for (int row = r0; row < r1; ++row) {
                if (row + 1 < r1) {
#pragma unroll
                    for (int j = 0; j < 2; ++j) { const int head = (j * 64 + lane) >> 4; n1[j] = *(const u32x4*)(R2 + (size_t)(row + 1) * 2048 + head * 256 + wi); n2[j] = *(const u32x4*)(R2 + (size_t)(row + 1) * 2048 + head * 256 + 128 + wi); } }
                const bool isc = (row % RPB) < CTXL;
                if (!(last && isc)) {
#pragma unroll
                for (int j = 0; j < 2; ++j) { const int head = (j * 64 + lane) >> 4; const u32x4 w1 = q1[j], w2 = q2[j];
                    float d[8] = {bflo(w1.x) - lam * bflo(w2.x), bfhi(w1.x) - lam * bfhi(w2.x), bflo(w1.y) - lam * bflo(w2.y), bfhi(w1.y) - lam * bfhi(w2.y),
                                  bflo(w1.z) - lam * bflo(w2.z), bfhi(w1.z) - lam * bfhi(w2.z), bflo(w1.w) - lam * bflo(w2.w), bfhi(w1.w) - lam * bfhi(w2.w)};
                    float ss = 0.f;
#pragma unroll
                    for (int e = 0; e < 8; ++e) ss += d[e] * d[e];
                    const float rstd = __builtin_amdgcn_rsqf(sum16(ss) * (1.0f / 128.0f) + EPS);
                    u32x4 o; o.x = cvt_pk_bf16(d[0] * rstd * g0.x, d[1] * rstd * g0.y); o.y = cvt_pk_bf16(d[2] * rstd * g0.z, d[3] * rstd * g0.w);
                    o.z = cvt_pk_bf16(d[4] * rstd * g1.x, d[5] * rstd * g1.y); o.w = cvt_pk_bf16(d[6] * rstd * g1.z, d[7] * rstd * g1.w);
                    *(u32x4*)(R3 + (size_t)row * DM + head * 128 + wi) = o; }
                }
#pragma unroll
                for (int j = 0; j < 2; ++j) { q1[j] = n1[j]; q2[j] = n2[j]; }
            }
        } break;
        case K_FINAL: {
            const float* fn = AIN(20);
            const int NLAT = fuse_ok ? 0 : NB * SEQ, rpw = (((NB * SEQ + NGW - 1) / NGW) + 3) & ~3, r0 = gw * rpw, r1 = (r0 + rpw < NLAT) ? r0 + rpw : NLAT;
            f32x4 v[4][4] = {}, vn[4][4] = {}, fw[4];
#pragma unroll
            for (int j = 0; j < 4; ++j) fw[j] = ((const f32x4*)fn)[lane + 64 * j];
#pragma unroll
            for (int q = 0; q < 4; ++q) if (r0 + q < r1) {
#pragma unroll
                for (int j = 0; j < 4; ++j) v[q][j] = ((const f32x4*)(xl_ws + (size_t)(r0 + q) * DM))[lane + 64 * j]; }
            for (int row = r0; row < r1; row += 4) {
#pragma unroll
                for (int q = 0; q < 4; ++q) if (row + 4 + q < r1) {
#pragma unroll
                    for (int j = 0; j < 4; ++j) vn[q][j] = ((const f32x4*)(xl_ws + (size_t)(row + 4 + q) * DM))[lane + 64 * j]; }
                float rstd[4];
#pragma unroll
                for (int q = 0; q < 4; ++q) { float ss = 0.f;
#pragma unroll
                    for (int j = 0; j < 4; ++j) ss += (v[q][j].x * v[q][j].x + v[q][j].y * v[q][j].y) + (v[q][j].z * v[q][j].z + v[q][j].w * v[q][j].w);
                    rstd[q] = __builtin_amdgcn_rsqf(wave_sum(ss) * (1.0f / DM) + EPS); }
#pragma unroll
                for (int q = 0; q < 4; ++q) if (row + q < r1) { f32x4* xr = (f32x4*)(xl_ws + (size_t)(row + q) * DM);
#pragma unroll
                    for (int j = 0; j < 4; ++j) xr[lane + 64 * j] = v[q][j] * rstd[q] * fw[j]; }
#pragma unroll
                for (int q = 0; q < 4; ++q)
#pragma unroll
                    for (int j = 0; j < 4; ++j) v[q][j] = vn[q][j];
            }
        } break;
        default: break;
        }
#ifndef NO_GEMM
        if (gk == 1) pg8::gemm_phase<pg8::EpiStore>(lds, gd, gS, eS);
        else if (gk == 2) {
            for (int it = 0; it < 1 + gk2; ++it) {
                const int rep = (gk2 && bx < 128) ? 1 - it : it;
                const pg8::Gemm g_ = rep ? gd2 : gd; const pg8::Order s_ = rep ? gS2 : gS; pg8::EpiResid e_ = eR; e_.part = rep ? part2 : nullptr;
                pg8::gemm_phase<pg8::EpiResid>(lds, g_, s_, e_);
            }
        }
        else if (gk == 3) { pg8::EpiSwiGLU E{R1}; pg8::gemm_phase<pg8::EpiSwiGLU>(lds, gd, gS, E); }
        else if (gk == 5) { pg8::EpiQkvNorm E{R1, ropeB, AIN(15), AIN(16), lds + pg8::STAGE_BYTES}; pg8::gemm_phase<pg8::EpiQkvNorm>(lds, gd, gS, E); }
        else if (gk == 4) {
            for (int rep = 0; rep < 2; ++rep) {
                if (rep == 0) { gS.init(16, 4, 8, G, bx); gd = pg8::Gemm{(const bf16_t*)((unsigned char*)R2 + R2_CS_OFF), R3, 4096, 4096, 4096, 0, (size_t)1024 * 4096 * 2}; }
                else { gS.init(1, 4, 8, G, bx); gd = pg8::Gemm{(const bf16_t*)(ws + WS_CSCTX), (const bf16_t*)((unsigned char*)R3 + R3_HTC_OFF), 256, 256, 256, 0, (size_t)1024 * 256 * 2}; }
                pg8::EpiPosDft E{R1, rep == 0 ? CTXL : 0, rep == 0 ? SEQ : CTXL}; pg8::gemm_phase<pg8::EpiPosDft>(lds, gd, gS, E);
            }
        }
#endif
        if (sl_ + 1 < args.ph_hi) {
            if (MK_PER_PHASE || ka->ph_lo < 0) grid.sync();
            else { unsigned* bw = (unsigned*)(ka->ws + WS_BAR); xcd_barrier(bw, bar_st); }
        }
    }
}

extern "C" void kernel_launch(void* const* d_in, const int* in_sizes, int n_in, void* d_out, int out_size, void* d_ws, size_t ws_size, hipStream_t stream) {
    static int grid = 0;
    if (grid == 0) {
        if (n_in != 21 || in_sizes[0] != NB * SEQ * DM || out_size != NB * SEQ * DM || ws_size < WS_END) {
            fprintf(stderr, "kernel_launch: unexpected shapes: n_in %d in0 %d out %d ws %zu (need >= %zu)\n", n_in, n_in > 0 ? in_sizes[0] : -1, out_size, ws_size, (size_t)WS_END); grid = -1; return; }
        int dev = 0, cus = 0, per_cu = 0;
        if (hipGetDevice(&dev) != hipSuccess || hipDeviceGetAttribute(&cus, hipDeviceAttributeMultiprocessorCount, dev) != hipSuccess) { fprintf(stderr, "kernel_launch: device query failed\n"); grid = -1; return; }
        if (hipFuncSetAttribute((const void*)fwd_megakernel, hipFuncAttributeMaxDynamicSharedMemorySize, LDS_BYTES) != hipSuccess) { fprintf(stderr, "kernel_launch: hipFuncSetAttribute failed\n"); grid = -1; return; }
        if (hipOccupancyMaxActiveBlocksPerMultiprocessor(&per_cu, (const void*)fwd_megakernel, 512, LDS_BYTES) != hipSuccess || per_cu < 1) { fprintf(stderr, "kernel_launch: occupancy query gave %d\n", per_cu); per_cu = 1; }
        (void)hipGetLastError();
        grid = cus * 1;
    }
    if (grid < 0) return;
    if (hipMemsetAsync((char*)d_ws + WS_BAR, 0, 65536 + 8 * 128 * 64 * 4, stream) != hipSuccess) { fprintf(stderr, "kernel_launch: memset of barrier words failed\n"); return; }
    Args a{};
    for (int i = 0; i < 21; ++i) a.in[i] = (const float*)d_in[i];
    a.out = (float*)d_out; a.ws = (unsigned char*)d_ws;
#if MK_PER_PHASE
    for (int ph = 0; ph < N_PHASES; ++ph) {
        a.ph_lo = ph; a.ph_hi = ph + 1; void* kargs[] = {&a};
        hipError_t e = hipLaunchCooperativeKernel((const void*)fwd_megakernel, dim3(grid), dim3(512), kargs, LDS_BYTES, stream);
        if (e != hipSuccess) { fprintf(stderr, "kernel_launch: launch (phase %d) failed: %s (grid %d)\n", ph, hipGetErrorString(e), grid); break; }
    }
#else
#ifdef PROBE_MASK
    a.ph_lo = 0; a.ph_hi = 2 * N_PHASES;
#else
    a.ph_lo = 0; a.ph_hi = N_PHASES;
#endif
    void* kargs[] = {&a};
    hipError_t e = hipLaunchCooperativeKernel((const void*)fwd_megakernel, dim3(grid), dim3(512), kargs, LDS_BYTES, stream);
    if (e != hipSuccess) fprintf(stderr, "kernel_launch: cooperative launch failed: %s (grid %d)\n", hipGetErrorString(e), grid);
#endif
}
```
